# Optimizing an MI355X kernel written in HIP

```python
import jax, jax.numpy as jnp
from jax import lax
import numpy as np

D_MODEL = 1024
BATCH = 8
SEQ = 8192
DEPTH = 2

PLE_DIM = 256
HEAD_DIM = 64
BRANCH_WIDTH = D_MODEL // 2
N_BRANCHES = 3
NSA_HEADS = BRANCH_WIDTH // HEAD_DIM
NSA_KV_GROUPS = 2
NSA_HPG = NSA_HEADS // NSA_KV_GROUPS
NSA_KV_WIDTH = NSA_KV_GROUPS * HEAD_DIM
NSA_GATE_WIDTH = 3 * NSA_HEADS
CMP_BLOCK = 32
CMP_STRIDE = 16
CMP_HIDDEN = 2 * HEAD_DIM
SEL_BLOCK = 64
SEL_TOPK = 16
WINDOW = 512
Q_BLOCK = 128
SG_GROUPS = 8
SG_CHUNK = 128
RWKV_HEADS = BRANCH_WIDTH // HEAD_DIM
DECAY_LORA = 64
AAA_LORA = 64
RK_SHIFT_WIDTH = 3 * BRANCH_WIDTH + DECAY_LORA + AAA_LORA
IN_SIZES = (BRANCH_WIDTH, 6 * NSA_KV_WIDTH, NSA_GATE_WIDTH, BRANCH_WIDTH,
            BRANCH_WIDTH, BRANCH_WIDTH, BRANCH_WIDTH,
            RK_SHIFT_WIDTH, BRANCH_WIDTH, N_BRANCHES * D_MODEL)
N_IN = 7 * BRANCH_WIDTH + 6 * NSA_KV_WIDTH + NSA_GATE_WIDTH + RK_SHIFT_WIDTH + N_BRANCHES * D_MODEL

NORM_EPS = 1e-6
LN_EPS = 1e-5
GN_EPS = 64e-5
MASK_NEG = -1e30
FORCE_BONUS = 1e4

kernel_name = "hybrid_nsa_sgmlp_rwkv7_block"


def _rmsnorm(x, g):
    xf = x.astype(jnp.float32)
    y = xf * lax.rsqrt(jnp.mean(xf * xf, axis=-1, keepdims=True) + NORM_EPS)
    return y.astype(x.dtype) * g


def _masked_softmax(s, mask):
    s = jnp.where(mask, s.astype(jnp.float32), MASK_NEG)
    return jnp.where(mask, jax.nn.softmax(s, axis=-1), 0.0)


def _split_cols(proj):
    out, off = [], 0
    for n in IN_SIZES:
        out.append(proj[..., off:off + n])
        off += n
    return out


def _compress(kv, w1, w2, pe):
    S = kv.shape[1]
    n_cmp = (S - CMP_BLOCK) // CMP_STRIDE + 1
    idx = jnp.arange(n_cmp)[:, None] * CMP_STRIDE + jnp.arange(CMP_BLOCK)[None, :]
    blk = kv[:, idx] + pe[:, None, :]
    hid = jax.nn.silu(jnp.einsum('bnlgd,ldh->bngh', blk, w1))
    return jnp.einsum('bngh,hd->bngd', hid, w2)


def _nsa(q, kc, vc, ks, vs, kw, vw, gate, cmp_w1, cmp_w2, cmp_pe):
    B, S, _ = q.shape
    G, HPG, Dh = NSA_KV_GROUPS, NSA_HPG, HEAD_DIM
    q = q.reshape(B, S, G, HPG, Dh) * (Dh ** -0.5)
    gate = jax.nn.sigmoid(gate).reshape(B, S, G, HPG, 3)
    k_cmp = _compress(kc.reshape(B, S, G, Dh), cmp_w1[0], cmp_w2[0], cmp_pe[0])
    v_cmp = _compress(vc.reshape(B, S, G, Dh), cmp_w1[1], cmp_w2[1], cmp_pe[1])
    n_cmp = k_cmp.shape[1]
    cmp_start = jnp.arange(n_cmp) * CMP_STRIDE
    cmp_end = cmp_start + CMP_BLOCK - 1
    n_slc = S // SEL_BLOCK
    top_k = min(SEL_TOPK, n_slc)
    slc_start = jnp.arange(n_slc) * SEL_BLOCK
    cover = ((cmp_start[:, None] <= slc_start[None, :] + SEL_BLOCK - 1)
             & (cmp_end[:, None] >= slc_start[None, :])).astype(jnp.float32)
    k_slc = ks.reshape(B, n_slc, SEL_BLOCK, G, Dh).transpose(0, 3, 1, 2, 4)
    v_slc = vs.reshape(B, n_slc, SEL_BLOCK, G, Dh).transpose(0, 3, 1, 2, 4)
    k_win = jnp.pad(kw.reshape(B, S, G, Dh), ((0, 0), (WINDOW, 0), (0, 0), (0, 0)))
    v_win = jnp.pad(vw.reshape(B, S, G, Dh), ((0, 0), (WINDOW, 0), (0, 0), (0, 0)))
    gather_blocks = jax.vmap(jax.vmap(lambda blocks, ix: blocks[ix]))
    j = jnp.arange(n_slc)

    def block(qb):
        q0 = qb * Q_BLOCK
        qblk = lax.dynamic_slice_in_dim(q, q0, Q_BLOCK, axis=1)
        gblk = lax.dynamic_slice_in_dim(gate, q0, Q_BLOCK, axis=1)
        t = q0 + jnp.arange(Q_BLOCK)
        valid_c = cmp_end[None, :] <= t[:, None]
        p_c = _masked_softmax(jnp.einsum('bqghd,bngd->bghqn', qblk, k_cmp), valid_c)
        o_c = jnp.einsum('bghqn,bngd->bqghd', p_c.astype(q.dtype), v_cmp)
        imp = jnp.einsum('bghqn,nj->bgqj', p_c, cover)
        t_blk = t // SEL_BLOCK
        forced = (j[None, :] == 0) | (j[None, :] == t_blk[:, None]) | (j[None, :] == t_blk[:, None] - 1)
        causal_blk = slc_start[None, :] <= t[:, None]
        score = jnp.where(causal_blk, jnp.where(forced, FORCE_BONUS, imp), -FORCE_BONUS)
        _, sel = lax.top_k(score, top_k)
        k_sel = gather_blocks(k_slc, sel).reshape(B, G, Q_BLOCK, top_k * SEL_BLOCK, Dh)
        v_sel = gather_blocks(v_slc, sel).reshape(B, G, Q_BLOCK, top_k * SEL_BLOCK, Dh)
        pos_sel = (sel[..., None] * SEL_BLOCK + jnp.arange(SEL_BLOCK)).reshape(B, G, Q_BLOCK, top_k * SEL_BLOCK)
        valid_s = (pos_sel <= t[None, None, :, None])[:, :, None]
        p_s = _masked_softmax(jnp.einsum('bqghd,bgqkd->bghqk', qblk, k_sel), valid_s)
        o_s = jnp.einsum('bghqk,bgqkd->bqghd', p_s.astype(q.dtype), v_sel)
        kwb = lax.dynamic_slice_in_dim(k_win, q0, Q_BLOCK + WINDOW, axis=1)
        vwb = lax.dynamic_slice_in_dim(v_win, q0, Q_BLOCK + WINDOW, axis=1)
        pos_w = q0 - WINDOW + jnp.arange(Q_BLOCK + WINDOW)
        valid_w = ((pos_w[None, :] <= t[:, None]) & (pos_w[None, :] > t[:, None] - WINDOW)
                   & (pos_w[None, :] >= 0))
        p_w = _masked_softmax(jnp.einsum('bqghd,bkgd->bghqk', qblk, kwb), valid_w)
        o_w = jnp.einsum('bghqk,bkgd->bqghd', p_w.astype(q.dtype), vwb)
        return gblk[..., 0:1] * o_c + gblk[..., 1:2] * o_s + gblk[..., 2:3] * o_w

    out = lax.map(block, jnp.arange(S // Q_BLOCK))
    return jnp.moveaxis(out, 0, 1).reshape(B, S, G * HPG * Dh)


def _spatial_gating(u, v, ln_g, ln_b, w_s, b_s):
    B, S, C = v.shape
    vf = v.astype(jnp.float32)
    mu = jnp.mean(vf, axis=-1, keepdims=True)
    var = jnp.var(vf, axis=-1, keepdims=True)
    vn = ((vf - mu) * lax.rsqrt(var + LN_EPS)).astype(v.dtype) * ln_g + ln_b
    vn = vn.reshape(B, S // SG_CHUNK, SG_CHUNK, SG_GROUPS, C // SG_GROUPS)
    causal = jnp.tril(jnp.ones((SG_CHUNK, SG_CHUNK), dtype=bool))
    w = jnp.where(causal, w_s, 0.0)
    mixed = jnp.einsum('gts,bcsgd->bctgd', w, vn) + b_s.T[:, :, None]
    return u * mixed.reshape(B, S, C)


def _rwkv7(xs, mu, w0, w2, a0, a2, k_k, k_a, r_k, lnx_g, lnx_b):
    B, S, _ = xs.shape
    C, H, N = BRANCH_WIDTH, RWKV_HEADS, HEAD_DIM
    prev = jnp.pad(xs, ((0, 0), (1, 0), (0, 0)))[:, :-1]
    xs = xs + (prev - xs) * mu
    r, k, v, wl, al = jnp.split(xs, [C, 2 * C, 3 * C, 3 * C + DECAY_LORA], axis=-1)
    w = -jax.nn.softplus(-(w0 + jnp.tanh(wl) @ w2)) - 0.5
    a = jax.nn.sigmoid(a0 + al @ a2)
    r, k, v, w, a = (z.reshape(B, S, H, N) for z in (r, k, v, w, a))
    kkf = (k * k_k).astype(jnp.float32)
    kk = kkf / jnp.maximum(jnp.sqrt(jnp.sum(kkf * kkf, axis=-1, keepdims=True)), 1e-12)
    k = k * (1 + (a - 1) * k_a)
    decay = jnp.exp(-jnp.exp(w.astype(jnp.float32)))

    def step(state, inp):
        r_t, d_t, k_t, v_t, a_t, b_t = inp
        sa = jnp.einsum('bhij,bhj->bhi', state, a_t)
        state = (state * d_t[:, :, None, :] + sa[..., None] * b_t[:, :, None, :]
                 + v_t[..., None] * k_t[:, :, None, :])
        return state, jnp.einsum('bhij,bhj->bhi', state, r_t)

    seq = lambda z: jnp.moveaxis(z.astype(jnp.float32), 1, 0)
    state0 = jnp.zeros((B, H, N, N), jnp.float32)
    _, y = lax.scan(step, state0, (seq(r), seq(decay), seq(k), seq(v), seq(-kk), seq(kk * a)))
    y = jnp.moveaxis(y, 0, 1)
    m = jnp.mean(y, axis=-1, keepdims=True)
    var = jnp.var(y, axis=-1, keepdims=True)
    y = ((y - m) * lax.rsqrt(var + GN_EPS)).reshape(B, S, C) * lnx_g + lnx_b
    bonus = (jnp.sum(r * k * r_k, axis=-1, keepdims=True) * v).reshape(B, S, C)
    return (y + bonus).astype(xs.dtype)


def setup_inputs(seed: int = 0) -> dict:
    key = jax.random.key(seed)
    ks = iter(jax.random.split(key, 32))
    nrm = lambda shape, scale: jax.random.normal(next(ks), shape, jnp.float32) * scale
    L, D, W = DEPTH, D_MODEL, BRANCH_WIDTH
    return {
        "x": nrm((BATCH, SEQ, D), 1.0),
        "p": nrm((DEPTH, BATCH, SEQ, PLE_DIM), 1.0),
        "norm_g": 1.0 + nrm((L, D), 0.02),
        "w_in": nrm((L, D, N_IN), D ** -0.5),
        "cmp_w1": nrm((L, 2, CMP_BLOCK, HEAD_DIM, CMP_HIDDEN), (CMP_BLOCK * HEAD_DIM) ** -0.5),
        "cmp_w2": nrm((L, 2, CMP_HIDDEN, HEAD_DIM), CMP_HIDDEN ** -0.5),
        "cmp_pe": nrm((L, 2, CMP_BLOCK, HEAD_DIM), 0.5),
        "sg_ln_g": 1.0 + nrm((L, W), 0.02),
        "sg_ln_b": nrm((L, W), 0.02),
        "sg_w": nrm((L, SG_GROUPS, SG_CHUNK, SG_CHUNK), SG_CHUNK ** -0.5),
        "sg_b": 1.0 + nrm((L, SG_GROUPS, SG_CHUNK), 0.02),
        "rk_mu": jax.random.uniform(next(ks), (L, RK_SHIFT_WIDTH), jnp.float32),
        "rk_w0": -1.0 + nrm((L, W), 0.5),
        "rk_w2": nrm((L, DECAY_LORA, W), 0.5 * DECAY_LORA ** -0.5),
        "rk_a0": nrm((L, W), 0.1),
        "rk_a2": nrm((L, AAA_LORA, W), 0.5 * AAA_LORA ** -0.5),
        "rk_kk": 0.85 + nrm((L, RWKV_HEADS, HEAD_DIM), 0.02),
        "rk_ka": 1.0 + nrm((L, RWKV_HEADS, HEAD_DIM), 0.02),
        "rk_rk": nrm((L, RWKV_HEADS, HEAD_DIM), 0.1),
        "rk_lnx_g": 1.0 + nrm((L, W), 0.02),
        "rk_lnx_b": nrm((L, W), 0.02),
        "w_branch": nrm((L, N_BRANCHES, W, D), W ** -0.5),
        "w_o": nrm((L, D, D), D ** -0.5),
        "ple_norm_g": 1.0 + nrm((L, D), 0.02),
        "w_ple_gate": nrm((L, D, D), D ** -0.5),
        "w_ple_proj": nrm((L, PLE_DIM, D), PLE_DIM ** -0.5),
        "final_norm_g": 1.0 + nrm((D,), 0.02),
    }


def reference(x, p, norm_g, w_in, cmp_w1, cmp_w2, cmp_pe, sg_ln_g, sg_ln_b, sg_w, sg_b,
              rk_mu, rk_w0, rk_w2, rk_a0, rk_a2, rk_kk, rk_ka, rk_rk, rk_lnx_g, rk_lnx_b,
              w_branch, w_o, ple_norm_g, w_ple_gate, w_ple_proj, final_norm_g):
    B, S, D = x.shape
    for i in range(DEPTH):
        h = _rmsnorm(x, norm_g[i])
        proj = h @ w_in[i]
        nq, nkv, ngate, nz, su, sv, sz, rs, rz, mg = _split_cols(proj)
        nkc, nvc, nks, nvs, nkw, nvw = jnp.split(nkv, 6, axis=-1)
        y_nsa = _nsa(nq, nkc, nvc, nks, nvs, nkw, nvw, ngate, cmp_w1[i], cmp_w2[i], cmp_pe[i])
        y_sg = _spatial_gating(su, sv, sg_ln_g[i], sg_ln_b[i], sg_w[i], sg_b[i])
        y_rk = _rwkv7(rs, rk_mu[i], rk_w0[i], rk_w2[i], rk_a0[i], rk_a2[i], rk_kk[i], rk_ka[i],
                      rk_rk[i], rk_lnx_g[i], rk_lnx_b[i])
        ys = jnp.stack([y_nsa * jax.nn.silu(nz), y_sg * jax.nn.silu(sz), y_rk * jax.nn.silu(rz)], axis=2)
        zs = jnp.einsum('bsnc,ncd->bsnd', ys, w_branch[i])
        merge = jax.nn.sigmoid(mg).reshape(B, S, N_BRANCHES, D)
        x = x + jnp.sum(merge * zs, axis=2) @ w_o[i]
        hp = _rmsnorm(x, ple_norm_g[i])
        x = x + jax.nn.sigmoid(hp @ w_ple_gate[i]) * (p[i] @ w_ple_proj[i])
    return _rmsnorm(x, final_norm_g)
```

```cpp
#include <hip/hip_runtime.h>
#include <hip/hip_bf16.h>
#include <hip/hip_cooperative_groups.h>
#include <cstdio>
namespace cg = cooperative_groups;

typedef unsigned short u16;
using bf16x8 = __attribute__((ext_vector_type(8))) short;
using bf16x4 = __attribute__((ext_vector_type(4))) short;
using f32x4 = __attribute__((ext_vector_type(4))) float;

#define TOK 65536
#define SEQ 8192
#define LD 5632
#define C_Q 0
#define C_KC 512
#define C_VC 640
#define C_KS 768
#define C_KW 1024
#define C_NZ 1280
#define C_SU 1792
#define C_SV 2304
#define C_SZ 2816
#define C_RS 3328
#define C_RZ 4992
#define C_NG 5504
#define C_MS 3328

struct Params {
  const float *x, *p, *norm_g, *w_in, *cmp_w1, *cmp_w2, *cmp_pe, *sg_ln_g, *sg_ln_b, *sg_w, *sg_b,
      *rk_mu, *rk_w0, *rk_w2, *rk_a0, *rk_a2, *rk_kk, *rk_ka, *rk_rk, *rk_lnx_g, *rk_lnx_b,
      *w_branch, *w_o, *ple_norm_g, *w_ple_gate, *w_ple_proj, *final_norm_g;
  float* out;
  u16 *WinT, *WmgT, *WbrT, *WoT, *WgT, *WpT, *W1T, *W2T, *sgW, *w2T, *a2T, *kc, *vcT, *vsT, *vwT, *vnT, *proj, *hb;
  float *c1, *rstd, *rstd2, *mg;
  int* ctr;
};

__device__ __forceinline__ int TIDX_f() { int t = threadIdx.x; asm volatile("" : "+v"(t)); return t; }
__device__ __forceinline__ int BIDX_f() { int t = blockIdx.x; asm volatile("" : "+s"(t)); return t; }
typedef __bf16 hwbf2_t __attribute__((ext_vector_type(2)));
typedef float hwf2_t __attribute__((ext_vector_type(2)));
typedef unsigned u32x4_t __attribute__((ext_vector_type(4)));
__device__ __forceinline__ unsigned pack2(float a, float b) { hwf2_t v = {a, b}; hwbf2_t r = __builtin_convertvector(v, hwbf2_t); return __builtin_bit_cast(unsigned, r); }
__device__ __forceinline__ u16 f2bf(float f) { return (u16)(pack2(f, 0.f) & 0xffffu); }
__device__ __forceinline__ float bf2f(u16 h) { return __uint_as_float(((unsigned)h) << 16); }
__device__ __forceinline__ float sigmoidf_(float x) { return __builtin_amdgcn_rcpf(1.f + __expf(-x)); }
__device__ __forceinline__ float siluf_(float x) { return x * __builtin_amdgcn_rcpf(1.f + __expf(-x)); }
__device__ __forceinline__ float shx(float v, int m) { const int l = TIDX_f() & 63; return __int_as_float(__builtin_amdgcn_ds_bpermute((l ^ m) << 2, __float_as_int(v))); }
__device__ __forceinline__ int shx(int v, int m) { const int l = TIDX_f() & 63; return __builtin_amdgcn_ds_bpermute((l ^ m) << 2, v); }
__device__ __forceinline__ float sh15(float v) { const int l = TIDX_f() & 63; return __int_as_float(__builtin_amdgcn_ds_bpermute(((l & 48) | 15) << 2, __float_as_int(v))); }
__device__ __forceinline__ void wave_sync() {
  __builtin_amdgcn_fence(__ATOMIC_RELEASE, "wavefront");
  __builtin_amdgcn_wave_barrier();
  __builtin_amdgcn_fence(__ATOMIC_ACQUIRE, "wavefront");
}
#define MFMA(a, b, c) __builtin_amdgcn_mfma_f32_16x16x32_bf16((a), (b), (c), 0, 0, 0)
#define MFMA16(a, b, c) __builtin_amdgcn_mfma_f32_16x16x16bf16_1k((a), (b), (c), 0, 0, 0)
__device__ __forceinline__ bf16x8 pack8(float a0, float a1, float a2, float a3, float a4, float a5, float a6, float a7) {
  u32x4_t t = {pack2(a0, a1), pack2(a2, a3), pack2(a4, a5), pack2(a6, a7)};
  return __builtin_bit_cast(bf16x8, t);
}
__device__ __forceinline__ bf16x8 cat44(bf16x4 a, bf16x4 b) { bf16x8 r; r[0]=a[0]; r[1]=a[1]; r[2]=a[2]; r[3]=a[3]; r[4]=b[0]; r[5]=b[1]; r[6]=b[2]; r[7]=b[3]; return r; }
__device__ __forceinline__ bf16x8 zero8() { bf16x8 r = {0,0,0,0,0,0,0,0}; return r; }
__device__ __forceinline__ f32x4 zero4() { f32x4 r = {0.f,0.f,0.f,0.f}; return r; }
#define DPPF(v, ctrl) __int_as_float(__builtin_amdgcn_mov_dpp(__float_as_int(v), (ctrl), 0xF, 0xF, true))
__device__ __forceinline__ float red16_max(float v) { v = fmaxf(v, DPPF(v, 0xB1)); v = fmaxf(v, DPPF(v, 0x4E)); v = fmaxf(v, DPPF(v, 0x141)); v = fmaxf(v, DPPF(v, 0x140)); return v; }
__device__ __forceinline__ float red16_sum(float v) { v += DPPF(v, 0xB1); v += DPPF(v, 0x4E); v += DPPF(v, 0x141); v += DPPF(v, 0x140); return v; }

template <int MODE>
__device__ void tr_conv(const float* __restrict__ src, long sld, u16* __restrict__ dst, long dld, int K, int N, const float* __restrict__ scale, float* tile) {
  const int tk = K / 64, tn = N / 64;
  const int c = TIDX_f() & 63, r4 = TIDX_f() >> 6;
  for (int t = BIDX_f(); t < tk * tn; t += gridDim.x) {
    const int k0 = (t % tk) * 64, n0 = (t / tk) * 64;
    __syncthreads();
    int n = n0 + c, sc = n; bool ok = true;
    if (MODE == 1) { if (n < 1280) sc = n; else if (n < 5504) sc = n + 24; else if (n < 5528) sc = 1280 + (n - 5504); else ok = false; }
#pragma unroll 4
    for (int r = 0; r < 16; ++r) { int kk = r4 + 4 * r; float v = ok ? src[(long)(k0 + kk) * sld + sc] : 0.f; if (scale) v *= scale[k0 + kk]; tile[kk * 65 + c] = v; }
    __syncthreads();
#pragma unroll 4
    for (int r = 0; r < 16; ++r) { int nn = r4 + 4 * r; dst[(long)(n0 + nn) * dld + k0 + c] = f2bf(tile[c * 65 + nn]); }
  }
}

__device__ void phase_weights(const Params& P, char* lds) {
  float* tile = (float*)lds;
  const int gt = BIDX_f() * 256 + TIDX_f(), ngt = gridDim.x * 256;
  if (gt < 4) P.ctr[gt] = 0;
  for (int l = 0; l < 2; ++l) {
    tr_conv<1>(P.w_in + (long)l * 1024 * 9112, 9112, P.WinT + (long)l * LD * 1024, 1024, 1024, LD, P.norm_g + l * 1024, tile);
    tr_conv<0>(P.w_in + (long)l * 1024 * 9112 + 5528, 9112, P.WmgT + (long)l * 3072 * 1024, 1024, 1024, 3072, P.norm_g + l * 1024, tile);
    for (int n = 0; n < 3; ++n)
      tr_conv<0>(P.w_branch + (long)(l * 3 + n) * 512 * 1024, 1024, P.WbrT + (long)(l * 3 + n) * 1024 * 512, 512, 512, 1024, nullptr, tile);
    tr_conv<0>(P.w_o + (long)l * 1024 * 1024, 1024, P.WoT + (long)l * 1024 * 1024, 1024, 1024, 1024, nullptr, tile);
    tr_conv<0>(P.w_ple_gate + (long)l * 1024 * 1024, 1024, P.WgT + (long)l * 1024 * 1024, 1024, 1024, 1024, P.ple_norm_g + l * 1024, tile);
    tr_conv<0>(P.w_ple_proj + (long)l * 256 * 1024, 1024, P.WpT + (long)l * 1024 * 256, 256, 256, 1024, nullptr, tile);
    for (int kv = 0; kv < 2; ++kv) {
      for (int i = BIDX_f() * 256 + TIDX_f(); i < 2048 * 128; i += gridDim.x * 256) {
        const int h = i & 127, kk = i >> 7;
        const int di = ((kk >> 5) * 8 + (h >> 4)) * 512 + (((kk >> 3) & 3) * 16 + (h & 15)) * 8 + (kk & 7);
        P.W1T[(long)(l * 2 + kv) * 128 * 2048 + di] = f2bf(P.cmp_w1[(long)(l * 2 + kv) * 2048 * 128 + i]);
      }
      tr_conv<0>(P.cmp_w2 + (long)(l * 2 + kv) * 128 * 64, 64, P.W2T + (long)(l * 2 + kv) * 64 * 128, 128, 128, 64, nullptr, tile);
    }
    for (int i = BIDX_f() * 256 + TIDX_f(); i < 64 * 512; i += gridDim.x * 256) {
      const int jg = i & 511, m = i >> 9;
      const int h = jg >> 6, mt = (jg >> 4) & 3, j16 = jg & 15, ks = m >> 5, mm = m & 31;
      const int di = (((l * 8 + h) * 4 + mt) * 2 + ks) * 512 + (((mm >> 2) & 3) * 16 + j16) * 8 + (mm >> 4) * 4 + (mm & 3);
      P.w2T[di] = f2bf(P.rk_w2[(long)l * 64 * 512 + i]);
      P.a2T[di] = f2bf(P.rk_a2[(long)l * 64 * 512 + i]);
    }
  }
  for (int i = gt; i < 2 * 8 * 128 * 128; i += ngt) {
    const int s = i & 127, t = (i >> 7) & 127, lg = i >> 14;
    const int di = ((lg * 8 + (t >> 4)) * 4 + (s >> 5)) * 512 + (((s >> 3) & 3) * 16 + (t & 15)) * 8 + (s & 7);
    P.sgW[di] = (s <= t) ? f2bf(P.sg_w[i]) : (u16)0;
  }
  {
    const int lane_ = TIDX_f() & 63, gw_ = BIDX_f() * 4 + (TIDX_f() >> 6), nw_ = gridDim.x * 4;
    for (int o = gw_; o < 512; o += nw_) {
      const int h = o & 127, lk = o >> 7; const float* pe = P.cmp_pe + (long)lk * 2048; const float* w1 = P.cmp_w1 + (long)lk * 2048 * 128 + h; float s = 0.f;
#pragma unroll 8
      for (int k = lane_; k < 2048; k += 64) s += pe[k] * w1[(long)k * 128];
#pragma unroll
      for (int d = 32; d > 0; d >>= 1) s += shx(s, d);
      if (lane_ == 0) P.c1[o] = s;
    }
  }
}

__device__ void phase_rstd(const float* __restrict__ x, float* __restrict__ rstd, u16* __restrict__ hb, bool scaled) {
  const int lane = TIDX_f() & 63, gw = BIDX_f() * 4 + (TIDX_f() >> 6), nw = gridDim.x * 4;
  for (int row = gw; row < TOK; row += nw) {
    const float4* p = (const float4*)(x + (long)row * 1024);
    float4 v[4]; float s = 0.f;
#pragma unroll
    for (int i = 0; i < 4; ++i) { v[i] = p[lane + 64 * i]; s += v[i].x * v[i].x + v[i].y * v[i].y + v[i].z * v[i].z + v[i].w * v[i].w; }
#pragma unroll
    for (int o = 32; o > 0; o >>= 1) s += shx(s, o);
    float r = rsqrtf(s * (1.f / 1024.f) + 1e-6f);
    if (lane == 0) rstd[row] = r;
    if (hb) {
      const float r_ = r; (void)r_;
      if (!scaled) r = 1.f;
#pragma unroll
      for (int i = 0; i < 4; ++i) { uint2 o; o.x = pack2(v[i].x * r, v[i].y * r); o.y = pack2(v[i].z * r, v[i].w * r); *(uint2*)(hb + (long)row * 1024 + (lane + 64 * i) * 4) = o; }
    }
  }
}
__device__ void phase_final_norm(float* __restrict__ x, const float* __restrict__ g) {
  const int lane = TIDX_f() & 63, gw = BIDX_f() * 4 + (TIDX_f() >> 6), nw = gridDim.x * 4;
  for (int row = gw; row < TOK; row += nw) {
    float4* p = (float4*)(x + (long)row * 1024);
    float4 v[4]; float s = 0.f;
#pragma unroll
    for (int i = 0; i < 4; ++i) { v[i] = p[lane + 64 * i]; s += v[i].x * v[i].x + v[i].y * v[i].y + v[i].z * v[i].z + v[i].w * v[i].w; }
#pragma unroll
    for (int o = 32; o > 0; o >>= 1) s += shx(s, o);
    float r = rsqrtf(s * (1.f / 1024.f) + 1e-6f);
#pragma unroll
    for (int i = 0; i < 4; ++i) { float4 gg = ((const float4*)g)[lane + 64 * i]; float4 o; o.x = v[i].x * r * gg.x; o.y = v[i].y * r * gg.y; o.z = v[i].z * r * gg.z; o.w = v[i].w * r * gg.w; p[lane + 64 * i] = o; }
  }
}

template <bool AF32>
__device__ __forceinline__ uint4 ld_a(const void* __restrict__ Ap, long lda, int k0, int c) {
  if (AF32) return *(const uint4*)((const float*)Ap + (long)(c >> 4) * lda + k0 + (c & 15) * 4);
  return *(const uint4*)((const u16*)Ap + (long)(c >> 3) * lda + k0 + (c & 7) * 8);
}
template <bool AF32>
__device__ __forceinline__ void st_a(u16* sA, int c, uint4 v) {
  if (AF32) { uint2 o; o.x = pack2(__uint_as_float(v.x), __uint_as_float(v.y)); o.y = pack2(__uint_as_float(v.z), __uint_as_float(v.w)); *(uint2*)(sA + (c >> 4) * 72 + (c & 15) * 4) = o; }
  else *(uint4*)(sA + (c >> 3) * 72 + (c & 7) * 8) = v;
}
__device__ __forceinline__ uint4 ld_b(const u16* __restrict__ Bp, long ldb, int k0, int c) { return *(const uint4*)(Bp + (long)(c >> 3) * ldb + k0 + (c & 7) * 8); }
__device__ __forceinline__ void st_b(u16* sB, int c, uint4 v) { *(uint4*)(sB + (c >> 3) * 72 + (c & 7) * 8) = v; }

template <int NT, bool AF32>
__device__ __forceinline__ void gemm_acc(f32x4 (&acc)[4][NT], const void* __restrict__ Ap, long lda, const u16* __restrict__ Bp, long ldb, int K, u16* sA, u16* sB) {
  const int tid = TIDX_f(), lane = tid & 63, wid = tid >> 6, wr = wid >> 1, wc = wid & 1, l16 = lane & 15, q4 = lane >> 4;
  uint4 ra0, ra1, ra2, ra3, ra4, ra5, ra6, ra7, rb0, rb1, rb2, rb3;
  ra4 = ra5 = ra6 = ra7 = rb2 = rb3 = make_uint4(0, 0, 0, 0);
#define GLOAD(k0)                                                                                   \
  {                                                                                                 \
    ra0 = ld_a<AF32>(Ap, lda, (k0), tid); ra1 = ld_a<AF32>(Ap, lda, (k0), tid + 256);               \
    ra2 = ld_a<AF32>(Ap, lda, (k0), tid + 512); ra3 = ld_a<AF32>(Ap, lda, (k0), tid + 768);         \
    if (AF32) { ra4 = ld_a<AF32>(Ap, lda, (k0), tid + 1024); ra5 = ld_a<AF32>(Ap, lda, (k0), tid + 1280); \
                ra6 = ld_a<AF32>(Ap, lda, (k0), tid + 1536); ra7 = ld_a<AF32>(Ap, lda, (k0), tid + 1792); } \
    rb0 = ld_b(Bp, ldb, (k0), tid); rb1 = ld_b(Bp, ldb, (k0), tid + 256);                           \
    if (NT == 4) { rb2 = ld_b(Bp, ldb, (k0), tid + 512); rb3 = ld_b(Bp, ldb, (k0), tid + 768); }   \
  }
  GLOAD(0);
  for (int k0 = 0; k0 < K; k0 += 64) {
    __syncthreads();
    st_a<AF32>(sA, tid, ra0); st_a<AF32>(sA, tid + 256, ra1); st_a<AF32>(sA, tid + 512, ra2); st_a<AF32>(sA, tid + 768, ra3);
    if (AF32) { st_a<AF32>(sA, tid + 1024, ra4); st_a<AF32>(sA, tid + 1280, ra5); st_a<AF32>(sA, tid + 1536, ra6); st_a<AF32>(sA, tid + 1792, ra7); }
    st_b(sB, tid, rb0); st_b(sB, tid + 256, rb1);
    if (NT == 4) { st_b(sB, tid + 512, rb2); st_b(sB, tid + 768, rb3); }
    __syncthreads();
    if (k0 + 64 < K) GLOAD(k0 + 64);
#pragma unroll
    for (int ks = 0; ks < 2; ++ks) {
      bf16x8 af[4], bfr[NT];
#pragma unroll
      for (int m = 0; m < 4; ++m) af[m] = *(const bf16x8*)(sA + (wr * 64 + m * 16 + l16) * 72 + ks * 32 + q4 * 8);
#pragma unroll
      for (int n = 0; n < NT; ++n) bfr[n] = *(const bf16x8*)(sB + (wc * NT * 16 + n * 16 + l16) * 72 + ks * 32 + q4 * 8);
#pragma unroll
      for (int m = 0; m < 4; ++m)
#pragma unroll
        for (int n = 0; n < NT; ++n) acc[m][n] = MFMA(bfr[n], af[m], acc[m][n]);
    }
  }
#undef GLOAD
}

#define FOR_TILES(NTN)                                                                         \
  const int nsup_ = 32 * ((NTN) / 4);                                                          \
  const int xcd_ = BIDX_f() & 7, lid_ = BIDX_f() >> 3, nl_ = gridDim.x >> 3;              \
  for (int st_ = xcd_; st_ < nsup_; st_ += 8)                                                  \
    for (int w_ = lid_; w_ < 64; w_ += nl_)

#define TILE_MN(NTN) const int mt = (st_ / ((NTN) / 4)) * 16 + (w_ & 15), nt = (st_ % ((NTN) / 4)) * 4 + (w_ >> 4);

__device__ __forceinline__ void gemm_acc8(f32x4 (&acc)[4][8], const u16* __restrict__ Ap, long lda, const u16* __restrict__ Bp, long ldb, int K, u16* sA, u16* sB) {
  const int tid = TIDX_f(), lane = tid & 63, wid = tid >> 6, wr = wid >> 1, wc = wid & 1, l16 = lane & 15, q4 = lane >> 4;
  uint4 ra0, ra1, rb0, rb1, rb2, rb3;
#define LD32(P_, ld_, k0, c) (*(const uint4*)((P_) + (long)((c) >> 2) * (ld_) + (k0) + ((c) & 3) * 8))
#define ST32(S_, c, v) (*(uint4*)((S_) + ((c) >> 2) * 40 + ((c) & 3) * 8) = (v))
#define GLOAD8(k0)                                                             \
  {                                                                            \
    ra0 = LD32(Ap, lda, (k0), tid); ra1 = LD32(Ap, lda, (k0), tid + 256);      \
    rb0 = LD32(Bp, ldb, (k0), tid); rb1 = LD32(Bp, ldb, (k0), tid + 256);      \
    rb2 = LD32(Bp, ldb, (k0), tid + 512); rb3 = LD32(Bp, ldb, (k0), tid + 768); \
  }
  GLOAD8(0);
  for (int k0 = 0; k0 < K; k0 += 32) {
    __syncthreads();
    ST32(sA, tid, ra0); ST32(sA, tid + 256, ra1);
    ST32(sB, tid, rb0); ST32(sB, tid + 256, rb1); ST32(sB, tid + 512, rb2); ST32(sB, tid + 768, rb3);
    __syncthreads();
    if (k0 + 32 < K) GLOAD8(k0 + 32);
    bf16x8 af[4];
#pragma unroll
    for (int m = 0; m < 4; ++m) af[m] = *(const bf16x8*)(sA + (wr * 64 + m * 16 + l16) * 40 + q4 * 8);
#pragma unroll
    for (int hf = 0; hf < 2; ++hf) {
      bf16x8 bfr[4];
#pragma unroll
      for (int n = 0; n < 4; ++n) bfr[n] = *(const bf16x8*)(sB + (wc * 128 + (hf * 4 + n) * 16 + l16) * 40 + q4 * 8);
#pragma unroll
      for (int m = 0; m < 4; ++m)
#pragma unroll
        for (int n = 0; n < 4; ++n) acc[m][hf * 4 + n] = MFMA(bfr[n], af[m], acc[m][hf * 4 + n]);
    }
  }
#undef GLOAD8
#undef LD32
#undef ST32
}

__device__ void phase_inproj(const Params& P, int layer, const float* xin, char* lds) {
  u16* sA = (u16*)lds; u16* sB = sA + 128 * 40;
  const int lane = TIDX_f() & 63, wid = TIDX_f() >> 6, wr = wid >> 1, wc = wid & 1, l16 = lane & 15, q4 = lane >> 4;
  const u16* W = P.WinT + (long)layer * LD * 1024;
  const int xcd_ = BIDX_f() & 7, lid_ = BIDX_f() >> 3, nl_ = gridDim.x >> 3;
  for (int st_ = xcd_; st_ < 176; st_ += 8)
    for (int w_ = lid_; w_ < 64; w_ += nl_) {
      const int mt = (st_ / 11) * 32 + (w_ & 31), nt = (st_ % 11) * 2 + (w_ >> 5);
      f32x4 acc[4][8];
#pragma unroll
      for (int m = 0; m < 4; ++m)
#pragma unroll
        for (int n = 0; n < 8; ++n) acc[m][n] = zero4();
      gemm_acc8(acc, P.hb + (long)mt * 128 * 1024, 1024, W + (long)nt * 256 * 1024, 1024, 1024, sA, sB);
#pragma unroll
      for (int m = 0; m < 4; ++m) {
        const int row = mt * 128 + wr * 64 + m * 16 + l16;
        const float r = P.rstd[row];
#pragma unroll
        for (int n = 0; n < 8; ++n) {
          const int cb = nt * 256 + wc * 128 + n * 16;
          f32x4 v = acc[m][n] * r;
          const bool trs = (cb >= 896) && (cb < 1024), trw = (cb >= 1152) && (cb < 1280);
          const bool kss = (cb >= 768) && (cb < 896), ksw = (cb >= 1024) && (cb < 1152);
          if ((cb >= C_RS) && (cb < C_RZ)) {
            const int rel = cb - C_RS + q4 * 4, sb = rel & ~63, j = rel & 63;
            uint2 o; o.x = pack2(v[0], v[1]); o.y = pack2(v[2], v[3]);
            *(uint2*)(P.proj + (long)((row & ~15) + (j >> 4) * 4 + ((j >> 2) & 3)) * LD + C_RS + sb + (row & 15) * 4) = o;
          } else if (kss || ksw) {
            const int kbase = kss ? 768 : 1024;
            const int dd = cb - kbase + q4 * 4, g = dd >> 6, d = dd & 63;
            uint2 o; o.x = pack2(v[0], v[1]); o.y = pack2(v[2], v[3]);
            *(uint2*)(P.proj + (long)((row & ~15) + g * 8 + (d >> 3)) * LD + kbase + (row & 15) * 8 + (d & 7)) = o;
          } else if (!(trs || trw)) {
            uint2 o; o.x = pack2(v[0], v[1]); o.y = pack2(v[2], v[3]);
            *(uint2*)(P.proj + (long)row * LD + cb + q4 * 4) = o;
          } else {
            const int dd = cb - (trs ? 896 : 1152) + q4 * 4;
            const int b = row >> 13, s = row & 8191, g = dd >> 6, d = dd & 63;
            const int kk = s & 63;
            u16* dp = (trs ? P.vsT : P.vwT) + ((long)(b * 2 + g) * 128 + (s >> 6)) * 4096
                      + ((((d >> 4) * 2 + (kk >> 5)) * 64 + ((kk >> 3) & 3) * 16 + (d & 15)) * 8) + (kk & 7);
            dp[0] = f2bf(v[0]); dp[8] = f2bf(v[1]); dp[16] = f2bf(v[2]); dp[24] = f2bf(v[3]);
          }
        }
      }
    }
}

__device__ void phase_merge(const Params& P, int layer, const float* xin, char* lds) {
  u16* sA = (u16*)lds; u16* sB = sA + 128 * 72;
  const int lane = TIDX_f() & 63, wid = TIDX_f() >> 6, wr = wid >> 1, wc = wid & 1, l16 = lane & 15, q4 = lane >> 4;
  const u16* Wmg = P.WmgT + (long)layer * 3072 * 1024;
  const u16* Wbr = P.WbrT + (long)layer * 3 * 1024 * 512;
  FOR_TILES(8) {
    TILE_MN(8)
    unsigned zpk[4][4][2];
#pragma unroll
    for (int m = 0; m < 4; ++m)
#pragma unroll
      for (int n = 0; n < 4; ++n) { zpk[m][n][0] = 0u; zpk[m][n][1] = 0u; }
    for (int br = 0; br < 3; ++br) {
      unsigned gpk[4][4][2];
      {
        f32x4 a1[4][4];
#pragma unroll
        for (int m = 0; m < 4; ++m)
#pragma unroll
          for (int n = 0; n < 4; ++n) a1[m][n] = zero4();
        gemm_acc<4, false>(a1, P.hb + (long)mt * 128 * 1024, 1024, Wmg + ((long)br * 1024 + nt * 128) * 1024, 1024, 1024, sA, sB);
#pragma unroll
        for (int m = 0; m < 4; ++m) {
          const float rs = P.rstd[mt * 128 + wr * 64 + m * 16 + l16];
#pragma unroll
          for (int n = 0; n < 4; ++n) {
            gpk[m][n][0] = pack2(sigmoidf_(a1[m][n][0] * rs), sigmoidf_(a1[m][n][1] * rs));
            gpk[m][n][1] = pack2(sigmoidf_(a1[m][n][2] * rs), sigmoidf_(a1[m][n][3] * rs));
            __builtin_amdgcn_sched_barrier(0);
          }
        }
      }
      __builtin_amdgcn_sched_barrier(0);
      {
        f32x4 a2[4][4];
#pragma unroll
        for (int m = 0; m < 4; ++m)
#pragma unroll
          for (int n = 0; n < 4; ++n) a2[m][n] = zero4();
        const int ycol = (br == 0) ? C_NZ : (br == 1 ? C_SZ : C_RZ);
        gemm_acc<4, false>(a2, P.proj + (long)mt * 128 * LD + ycol, LD, Wbr + ((long)br * 1024 + nt * 128) * 512, 512, 512, sA, sB);
#pragma unroll
        for (int m = 0; m < 4; ++m)
#pragma unroll
          for (int n = 0; n < 4; ++n) {
            const float z0 = __uint_as_float(zpk[m][n][0] << 16) + __uint_as_float(gpk[m][n][0] << 16) * a2[m][n][0];
            const float z1 = __uint_as_float(zpk[m][n][0] & 0xffff0000u) + __uint_as_float(gpk[m][n][0] & 0xffff0000u) * a2[m][n][1];
            const float z2 = __uint_as_float(zpk[m][n][1] << 16) + __uint_as_float(gpk[m][n][1] << 16) * a2[m][n][2];
            const float z3 = __uint_as_float(zpk[m][n][1] & 0xffff0000u) + __uint_as_float(gpk[m][n][1] & 0xffff0000u) * a2[m][n][3];
            zpk[m][n][0] = pack2(z0, z1); zpk[m][n][1] = pack2(z2, z3);
            __builtin_amdgcn_sched_barrier(0);
          }
      }
      __builtin_amdgcn_sched_barrier(0);
    }
#pragma unroll
    for (int m = 0; m < 4; ++m) {
      const int row = mt * 128 + wr * 64 + m * 16 + l16;
#pragma unroll
      for (int n = 0; n < 4; ++n) {
        const int col = nt * 128 + wc * 64 + n * 16 + q4 * 4;
        uint2 o; o.x = zpk[m][n][0]; o.y = zpk[m][n][1];
        *(uint2*)(P.proj + (long)row * LD + C_MS + col) = o;
      }
    }
  }
}

__device__ void phase_wo(const Params& P, int layer, const float* xin, float* xout, char* lds) {
  u16* sA = (u16*)lds; u16* sB = sA + 128 * 72;
  const int lane = TIDX_f() & 63, wid = TIDX_f() >> 6, wr = wid >> 1, wc = wid & 1, l16 = lane & 15, q4 = lane >> 4;
  const u16* W = P.WoT + (long)layer * 1024 * 1024;
  FOR_TILES(8) {
    TILE_MN(8)
    f32x4 acc[4][4];
#pragma unroll
    for (int m = 0; m < 4; ++m)
#pragma unroll
      for (int n = 0; n < 4; ++n) acc[m][n] = zero4();
    gemm_acc<4, false>(acc, P.proj + (long)mt * 128 * LD + C_MS, LD, W + (long)nt * 128 * 1024, 1024, 1024, sA, sB);
#pragma unroll
    for (int m = 0; m < 4; ++m) {
      const int row = mt * 128 + wr * 64 + m * 16 + l16;
      float ss = 0.f;
#pragma unroll
      for (int n = 0; n < 4; ++n) {
        const int col = nt * 128 + wc * 64 + n * 16 + q4 * 4;
        float4 xi = *(const float4*)(xin + (long)row * 1024 + col);
        float4 o; o.x = xi.x + acc[m][n][0]; o.y = xi.y + acc[m][n][1]; o.z = xi.z + acc[m][n][2]; o.w = xi.w + acc[m][n][3];
        *(float4*)(xout + (long)row * 1024 + col) = o;
        uint2 hb2; hb2.x = pack2(o.x, o.y); hb2.y = pack2(o.z, o.w);
        *(uint2*)(P.hb + (long)row * 1024 + col) = hb2;
        ss += o.x * o.x + o.y * o.y + o.z * o.z + o.w * o.w;
      }
      ss += shx(ss, 16); ss += shx(ss, 32);
      if (q4 == 0) atomicAdd(P.rstd2 + row, ss);
    }
  }
}

__device__ void phase_ple(const Params& P, int layer, float* xio, char* lds) {
  u16* sA = (u16*)lds; u16* sB = sA + 128 * 72;
  const int lane = TIDX_f() & 63, wid = TIDX_f() >> 6, wr = wid >> 1, wc = wid & 1, l16 = lane & 15, q4 = lane >> 4;
  const u16* Wg = P.WgT + (long)layer * 1024 * 1024;
  const u16* Wp = P.WpT + (long)layer * 1024 * 256;
  const float* pl = P.p + (long)layer * TOK * 256;
  FOR_TILES(8) {
    TILE_MN(8)
    unsigned ppk[4][4][2];
    {
      f32x4 a2[4][4];
#pragma unroll
      for (int m = 0; m < 4; ++m)
#pragma unroll
        for (int n = 0; n < 4; ++n) a2[m][n] = zero4();
      gemm_acc<4, true>(a2, pl + (long)mt * 128 * 256, 256, Wp + (long)nt * 128 * 256, 256, 256, sA, sB);
#pragma unroll
      for (int m = 0; m < 4; ++m)
#pragma unroll
        for (int n = 0; n < 4; ++n) { ppk[m][n][0] = pack2(a2[m][n][0], a2[m][n][1]); ppk[m][n][1] = pack2(a2[m][n][2], a2[m][n][3]); }
    }
    __builtin_amdgcn_sched_barrier(0);
    f32x4 a1[4][4];
#pragma unroll
    for (int m = 0; m < 4; ++m)
#pragma unroll
      for (int n = 0; n < 4; ++n) a1[m][n] = zero4();
    gemm_acc<4, false>(a1, P.hb + (long)mt * 128 * 1024, 1024, Wg + (long)nt * 128 * 1024, 1024, 1024, sA, sB);
#pragma unroll
    for (int m = 0; m < 4; ++m) {
      const int row = mt * 128 + wr * 64 + m * 16 + l16;
      const float rs2 = rsqrtf(P.rstd2[row] * (1.f / 1024.f) + 1e-6f);
#pragma unroll
      for (int n = 0; n < 4; ++n) {
        const int col = nt * 128 + wc * 64 + n * 16 + q4 * 4;
        float4 xi = *(const float4*)(xio + (long)row * 1024 + col);
        float4 o;
        o.x = xi.x + sigmoidf_(a1[m][n][0] * rs2) * __uint_as_float(ppk[m][n][0] << 16);
        o.y = xi.y + sigmoidf_(a1[m][n][1] * rs2) * __uint_as_float(ppk[m][n][0] & 0xffff0000u);
        o.z = xi.z + sigmoidf_(a1[m][n][2] * rs2) * __uint_as_float(ppk[m][n][1] << 16);
        o.w = xi.w + sigmoidf_(a1[m][n][3] * rs2) * __uint_as_float(ppk[m][n][1] & 0xffff0000u);
        *(float4*)(xio + (long)row * 1024 + col) = o;
      }
    }
  }
}

__device__ void compress_item(const Params& P, int layer, int item) {
  const int lane = TIDX_f() & 63, l16 = lane & 15, q4 = lane >> 4;
  const int ntile = item & 31, kv = (item >> 5) & 1, g = (item >> 6) & 1, b = item >> 7;
  int n = ntile * 16 + l16; const int nl = n > 510 ? 510 : n;
  const u16* W1 = P.W1T + (long)(layer * 2 + kv) * 128 * 2048;
  const u16* W2 = P.W2T + (long)(layer * 2 + kv) * 64 * 128;
  const u16* src = P.proj + ((long)b * SEQ + 16 * nl) * LD + (kv ? C_VC : C_KC) + g * 64 + q4 * 8;
  f32x4 acc[8];
#pragma unroll
  for (int i = 0; i < 8; ++i) acc[i] = zero4();
#pragma unroll 2
  for (int kstep = 0; kstep < 64; ++kstep) {
    const int l = kstep >> 1, dofs = (kstep & 1) * 32;
    bf16x8 bf = *(const bf16x8*)(src + (long)l * LD + dofs);
#pragma unroll
    for (int mt = 0; mt < 8; ++mt) {
      bf16x8 af = *(const bf16x8*)(W1 + ((kstep * 8 + mt) * 64 + q4 * 16 + l16) * 8);
      acc[mt] = MFMA(af, bf, acc[mt]);
    }
  }
  const float* c1 = P.c1 + (layer * 2 + kv) * 128;
  bf16x8 hf[4];
#pragma unroll
  for (int ks = 0; ks < 4; ++ks) {
    float hv[8];
#pragma unroll
    for (int jj = 0; jj < 8; ++jj) { int mt = 2 * ks + (jj >> 2), reg = jj & 3; float v = acc[mt][reg] + c1[16 * mt + 4 * q4 + reg]; hv[jj] = siluf_(v); }
    hf[ks] = pack8(hv[0], hv[1], hv[2], hv[3], hv[4], hv[5], hv[6], hv[7]);
  }
  f32x4 o[4];
#pragma unroll
  for (int m2 = 0; m2 < 4; ++m2) {
    o[m2] = zero4();
#pragma unroll
    for (int ks = 0; ks < 4; ++ks) {
      const u16* wp = W2 + (long)(m2 * 16 + l16) * 128 + 32 * ks + 4 * q4;
      bf16x8 af = cat44(*(const bf16x4*)wp, *(const bf16x4*)(wp + 16));
      o[m2] = MFMA(af, hf[ks], o[m2]);
    }
  }
  const int bg = b * 2 + g;
  const bool valid = n <= 510;
#pragma unroll
  for (int m2 = 0; m2 < 4; ++m2) {
    const int d = 16 * m2 + 4 * q4;
    f32x4 v = o[m2]; if (!valid) v = zero4();
    const int nk = n & 63;
    if (kv == 0) {
      uint2 w; w.x = pack2(v[0], v[1]); w.y = pack2(v[2], v[3]);
      *(uint2*)(P.kc + ((long)bg * 8 + (n >> 6)) * 4096 + ((((nk >> 4) * 2 + (d >> 5)) * 64 + ((d >> 3) & 3) * 16 + (nk & 15)) * 8) + (d & 7)) = w;
    } else {
      u16* dp = P.vcT + ((long)bg * 8 + (n >> 6)) * 4096 + ((((d >> 4) * 2 + (nk >> 5)) * 64 + ((nk >> 3) & 3) * 16 + (d & 15)) * 8) + (nk & 7);
      dp[0] = f2bf(v[0]); dp[8] = f2bf(v[1]); dp[16] = f2bf(v[2]); dp[24] = f2bf(v[3]);
    }
  }
}

__device__ void sgprep_item(const Params& P, int layer, int item, char* lds) {
  u16* tile = (u16*)lds;
  const int tid = TIDX_f(), lane = tid & 63, w = tid >> 6;
  const int b = item >> 8, s0 = (item & 255) * 32;
  const float* lg = P.sg_ln_g + layer * 512 + lane * 8; const float* lb = P.sg_ln_b + layer * 512 + lane * 8;
  __syncthreads();
#pragma unroll
  for (int tk = 0; tk < 8; ++tk) {
    const long tok = (long)b * SEQ + s0 + w * 8 + tk;
    bf16x8 raw = *(const bf16x8*)(P.proj + tok * LD + C_SV + lane * 8);
    float v[8]; float s = 0.f;
#pragma unroll
    for (int k = 0; k < 8; ++k) { v[k] = bf2f((u16)raw[k]); s += v[k]; }
#pragma unroll
    for (int o = 32; o > 0; o >>= 1) s += shx(s, o);
    const float mean = s * (1.f / 512.f); float q = 0.f;
#pragma unroll
    for (int k = 0; k < 8; ++k) { v[k] -= mean; q += v[k] * v[k]; }
#pragma unroll
    for (int o = 32; o > 0; o >>= 1) q += shx(q, o);
    const float r = rsqrtf(q * (1.f / 512.f) + 1e-5f);
#pragma unroll
    for (int k = 0; k < 8; ++k) tile[(lane * 8 + k) * 40 + w * 8 + tk] = f2bf(v[k] * r * lg[k] + lb[k]);
  }
  __syncthreads();
#pragma unroll
  for (int i = 0; i < 8; ++i) { int idx = tid + 256 * i, ch = idx >> 2, seg = idx & 3; const int si = (s0 & 127) + seg * 8;
    *(uint4*)(P.vnT + (((((long)b * 64 + (s0 >> 7)) * 8 + (ch >> 6)) * 4 + ((ch >> 4) & 3)) * 4 + (si >> 5)) * 512 + (((si >> 3) & 3) * 16 + (ch & 15)) * 8) = *(const uint4*)(tile + ch * 40 + seg * 8); }
}

__device__ void sg_item(const Params& P, int layer, int si) {
  const int lane = TIDX_f() & 63, l16 = lane & 15, q4 = lane >> 4;
  const int w = si & 3, g = (si >> 2) & 7, c = (si >> 5) & 63, b = si >> 11;
  const u16* W = P.sgW + ((long)(layer * 8 + g) * 8) * 4 * 512;
  const u16* V = P.vnT + ((((long)b * 64 + c) * 8 + g) * 16) * 512;
  f32x4 acc[2][4];
#pragma unroll
  for (int i = 0; i < 2; ++i)
#pragma unroll
    for (int d = 0; d < 4; ++d) acc[i][d] = zero4();
  for (int ks = 0; ks < 4; ++ks) {
    if (32 * ks > (2 * w + 1) * 16 + 15) break;
    bf16x8 vf[4];
#pragma unroll
    for (int d = 0; d < 4; ++d) vf[d] = *(const bf16x8*)(V + ((d * 4 + ks) * 64 + lane) * 8);
#pragma unroll
    for (int ti = 0; ti < 2; ++ti) {
      bf16x8 wf = *(const bf16x8*)(W + (((2 * w + ti) * 4 + ks) * 64 + lane) * 8);
#pragma unroll
      for (int d = 0; d < 4; ++d) acc[ti][d] = MFMA(vf[d], wf, acc[ti][d]);
    }
  }
#pragma unroll
  for (int ti = 0; ti < 2; ++ti) {
    const int t = (2 * w + ti) * 16 + l16;
    const long tok = (long)b * SEQ + c * 128 + t;
    const float bias = P.sg_b[(layer * 8 + g) * 128 + t];
#pragma unroll
    for (int d = 0; d < 4; ++d) {
      const int ch = g * 64 + d * 16 + q4 * 4;
      bf16x4 u4 = *(const bf16x4*)(P.proj + tok * LD + C_SU + ch);
      bf16x4 z4 = *(const bf16x4*)(P.proj + tok * LD + C_SZ + ch);
      float o[4];
#pragma unroll
      for (int r = 0; r < 4; ++r) o[r] = bf2f((u16)u4[r]) * (acc[ti][d][r] + bias) * siluf_(bf2f((u16)z4[r]));
      uint2 ov; ov.x = pack2(o[0], o[1]); ov.y = pack2(o[2], o[3]);
      *(uint2*)(P.proj + tok * LD + C_SZ + ch) = ov;
    }
  }
}

struct AttnSt { f32x4 o[4]; float m[4], l[4]; };

__device__ __forceinline__ void load_k(bf16x8 (&kf)[4][2], const u16* __restrict__ Kp, long kstride, int l16, int q4) {
#pragma unroll
  for (int nt = 0; nt < 4; ++nt)
#pragma unroll
    for (int ks = 0; ks < 2; ++ks) kf[nt][ks] = *(const bf16x8*)(Kp + (long)(nt * 16 + ks * 4 + q4) * kstride + l16 * 8);
}
__device__ __forceinline__ void attn_block(AttnSt& st, const bf16x8 (&qf)[2], const bf16x8 (&kf)[4][2], const u16* __restrict__ VTp, long vstride,
                                           const bool (&valid)[4], u16* pbuf, int l16, int q4) {
  bf16x8 vf[4][2];
#pragma unroll
  for (int dt = 0; dt < 4; ++dt)
#pragma unroll
    for (int ks = 0; ks < 2; ++ks) vf[dt][ks] = *(const bf16x8*)(VTp + ((dt * 2 + ks) * 64 + q4 * 16 + l16) * 8);
  f32x4 s[4];
#pragma unroll
  for (int nt = 0; nt < 4; ++nt) { s[nt] = MFMA(qf[0], kf[nt][0], zero4()); s[nt] = MFMA(qf[1], kf[nt][1], s[nt]); }
#pragma unroll
  for (int nt = 0; nt < 4; ++nt) { const float bsc = valid[nt] ? 0.f : -1e30f; const f32x4 bv = {bsc, bsc, bsc, bsc}; s[nt] = s[nt] * 0.18033688f + bv; }
  f32x4 mv = {st.m[0], st.m[1], st.m[2], st.m[3]};
  const f32x4 mxl = __builtin_elementwise_max(__builtin_elementwise_max(s[0], s[1]), __builtin_elementwise_max(s[2], s[3]));
  const f32x4 dm = mxl - mv;
  const bool need = (dm[0] > 8.f) || (dm[1] > 8.f) || (dm[2] > 8.f) || (dm[3] > 8.f);
  if (__builtin_amdgcn_ballot_w64(need) != 0ull) {
#pragma unroll
    for (int r = 0; r < 4; ++r) {
      const float mx = red16_max(mxl[r]);
      const float mnew = fmaxf(st.m[r], mx);
      const float alpha = __builtin_amdgcn_exp2f(st.m[r] - mnew);
      st.l[r] *= alpha; st.m[r] = mnew; mv[r] = mnew;
#pragma unroll
      for (int dt = 0; dt < 4; ++dt) st.o[dt][r] *= alpha;
    }
  }
  f32x4 rsv = zero4();
#pragma unroll
  for (int nt = 0; nt < 4; ++nt) {
    const f32x4 d = s[nt] - mv;
    f32x4 p;
#pragma unroll
    for (int r = 0; r < 4; ++r) p[r] = __builtin_amdgcn_exp2f(d[r]);
    s[nt] = p; rsv += p;
  }
#pragma unroll
  for (int r = 0; r < 4; ++r) st.l[r] += rsv[r];
#pragma unroll
  for (int nt = 0; nt < 4; ++nt)
#pragma unroll
    for (int r = 0; r < 4; ++r) pbuf[(q4 * 4 + r) * 72 + nt * 16 + l16] = f2bf(s[nt][r]);
  wave_sync();
  bf16x8 pf[2];
  pf[0] = *(const bf16x8*)(pbuf + l16 * 72 + q4 * 8);
  pf[1] = *(const bf16x8*)(pbuf + l16 * 72 + 32 + q4 * 8);
  wave_sync();
#pragma unroll
  for (int dt = 0; dt < 4; ++dt) { st.o[dt] = MFMA(pf[0], vf[dt][0], st.o[dt]); st.o[dt] = MFMA(pf[1], vf[dt][1], st.o[dt]); }
}

__device__ void nsa_item(const Params& P, int wi, char* wlds) {
  float* pl = (float*)wlds;
  u16* pbuf = (u16*)(wlds + 8192);
  unsigned* flags = (unsigned*)(wlds + 8192 + 2304);
  const int lane = TIDX_f() & 63, l16 = lane & 15, q4 = lane >> 4;
  const int bg = wi >> 11, b = bg >> 1, g = bg & 1;
  const int t0 = (2047 - (wi & 2047)) * 4;
  u16* proj = P.proj;
  const long tokb = (long)b * SEQ;
  const int tme = t0 + q4;
  bf16x8 qf[2];
  { const u16* qp = proj + (tokb + t0 + (l16 >> 2)) * LD + C_Q + g * 256 + (l16 & 3) * 64 + q4 * 8; qf[0] = *(const bf16x8*)qp; qf[1] = *(const bf16x8*)(qp + 32); }
  float gate[4][3];
  { const u16* gp = proj + (tokb + tme) * LD + C_NG + g * 12;
#pragma unroll
    for (int r = 0; r < 4; ++r)
#pragma unroll
      for (int x = 0; x < 3; ++x) gate[r][x] = sigmoidf_(bf2f(gp[r * 3 + x])); }
  f32x4 y[4];
#pragma unroll
  for (int d = 0; d < 4; ++d) y[d] = zero4();
#pragma unroll
  for (int i = 0; i < 8; ++i) *(float4*)(pl + lane * 32 + i * 4) = make_float4(0.f, 0.f, 0.f, 0.f);
  wave_sync();
  {
    const u16* Kc = P.kc + (long)bg * 512 * 64;
    const u16* VcT = P.vcT + (long)bg * 8 * 4096;
    const int nmax_me = (tme - 31) >> 4;
    const int nmax_hi = (t0 + 3 - 31) >> 4;
    const int nblk = nmax_hi >= 0 ? (nmax_hi >> 6) + 1 : 0;
    float m[4], l[4];
#pragma unroll
    for (int r = 0; r < 4; ++r) { m[r] = -1e30f; l[r] = 0.f; }
    for (int blk = 0; blk < nblk; ++blk) {
      f32x4 s[4]; bool valid[4];
#pragma unroll
      for (int nt = 0; nt < 4; ++nt) {
        const u16* kp = Kc + (long)blk * 4096 + ((nt * 2) * 64 + q4 * 16 + l16) * 8;
        s[nt] = MFMA(qf[0], *(const bf16x8*)kp, zero4()); s[nt] = MFMA(qf[1], *(const bf16x8*)(kp + 512), s[nt]);
        valid[nt] = (blk * 64 + nt * 16 + l16) <= nmax_me;
      }
#pragma unroll
      for (int r = 0; r < 4; ++r) {
        float mx = -1e30f;
#pragma unroll
        for (int nt = 0; nt < 4; ++nt) { float sv = valid[nt] ? s[nt][r] * 0.18033688f : -1e30f; s[nt][r] = sv; mx = fmaxf(mx, sv); }
        mx = red16_max(mx);
        const float mnew = fmaxf(m[r], mx);
        float rs = 0.f;
#pragma unroll
        for (int nt = 0; nt < 4; ++nt) rs += valid[nt] ? __builtin_amdgcn_exp2f(s[nt][r] - mnew) : 0.f;
        l[r] = l[r] * __builtin_amdgcn_exp2f(m[r] - mnew) + rs; m[r] = mnew;
      }
    }
    float il[4];
#pragma unroll
    for (int r = 0; r < 4; ++r) { const float lt = red16_sum(l[r]); il[r] = lt > 0.f ? 1.f / lt : 0.f; }
    f32x4 oc[4];
#pragma unroll
    for (int d = 0; d < 4; ++d) oc[d] = zero4();
    for (int blk = 0; blk < nblk; ++blk) {
      f32x4 s[4];
#pragma unroll
      for (int nt = 0; nt < 4; ++nt) {
        const u16* kp = Kc + (long)blk * 4096 + ((nt * 2) * 64 + q4 * 16 + l16) * 8;
        s[nt] = MFMA(qf[0], *(const bf16x8*)kp, zero4()); s[nt] = MFMA(qf[1], *(const bf16x8*)(kp + 512), s[nt]);
        const bool valid = (blk * 64 + nt * 16 + l16) <= nmax_me;
        float ps = 0.f;
#pragma unroll
        for (int r = 0; r < 4; ++r) { float p = valid ? __builtin_amdgcn_exp2f(s[nt][r] * 0.18033688f - m[r]) * il[r] : 0.f; s[nt][r] = p; ps += p; }
        pl[q4 * 512 + blk * 64 + nt * 16 + l16] = ps;
#pragma unroll
        for (int r = 0; r < 4; ++r) pbuf[(q4 * 4 + r) * 72 + nt * 16 + l16] = f2bf(s[nt][r]);
      }
      wave_sync();
      bf16x8 pf0 = *(const bf16x8*)(pbuf + l16 * 72 + q4 * 8);
      bf16x8 pf1 = *(const bf16x8*)(pbuf + l16 * 72 + 32 + q4 * 8);
      wave_sync();
#pragma unroll
      for (int dt = 0; dt < 4; ++dt) {
        const u16* vp = VcT + (long)blk * 4096 + ((dt * 2) * 64 + q4 * 16 + l16) * 8;
        oc[dt] = MFMA(pf0, *(const bf16x8*)vp, oc[dt]); oc[dt] = MFMA(pf1, *(const bf16x8*)(vp + 512), oc[dt]);
      }
    }
#pragma unroll
    for (int dt = 0; dt < 4; ++dt)
#pragma unroll
      for (int r = 0; r < 4; ++r) y[dt][r] += gate[r][0] * oc[dt][r];
  }
  wave_sync();
  const int tblk = t0 >> 6;
  {
    unsigned key[8]; unsigned selm = 0;
    const int need = 16 - (tblk == 0 ? 1 : (tblk == 1 ? 2 : 3));
#pragma unroll
    for (int k = 0; k < 8; ++k) {
      const int j = l16 * 8 + k;
      float imp = 0.f;
#pragma unroll
      for (int i = -1; i <= 3; ++i) { int ii = 4 * j + i; if (ii >= 0 && ii <= 510) imp += pl[q4 * 512 + ii]; }
      const bool forced = (j == 0) || (j == tblk) || (j == tblk - 1);
      const bool cand = (j <= tblk) && !forced;
      key[k] = cand ? ((__float_as_uint(imp) & ~127u) | (unsigned)(127 - j)) : 0u;
      if (forced && j <= tblk) selm |= 1u << k;
    }
    for (int it = 0; it < 13; ++it) {
      unsigned mx = 0;
#pragma unroll
      for (int k = 0; k < 8; ++k) mx = key[k] > mx ? key[k] : mx;
      mx = max(mx, (unsigned)shx((int)mx, 1)); mx = max(mx, (unsigned)shx((int)mx, 2));
      mx = max(mx, (unsigned)shx((int)mx, 4)); mx = max(mx, (unsigned)shx((int)mx, 8));
      const bool act = (it < need) && (mx != 0u);
#pragma unroll
      for (int k = 0; k < 8; ++k) if (act && key[k] == mx) { selm |= 1u << k; key[k] = 0u; }
    }
#pragma unroll
    for (int k = 0; k < 8; ++k) {
      const unsigned long long bal = __ballot((selm >> k) & 1u);
      if (q4 == 0) {
        unsigned wd = (unsigned)((bal >> l16) & 1ull) | ((unsigned)((bal >> (16 + l16)) & 1ull) << 1) | ((unsigned)((bal >> (32 + l16)) & 1ull) << 2) | ((unsigned)((bal >> (48 + l16)) & 1ull) << 3);
        flags[l16 * 8 + k] = wd;
      }
    }
  }
  wave_sync();
  {
    AttnSt st;
#pragma unroll
    for (int d = 0; d < 4; ++d) st.o[d] = zero4();
#pragma unroll
    for (int r = 0; r < 4; ++r) { st.m[r] = -1e4f; st.l[r] = 0.f; }
    const u16* Kb = proj + (tokb + g * 8) * LD + C_KS;
    const u16* Vb = P.vsT + (long)bg * 128 * 4096;
    int j = 0;
    while (j <= tblk && __builtin_amdgcn_readfirstlane(flags[j]) == 0u) ++j;
    bf16x8 kA[4][2], kB[4][2];
    if (j <= tblk) load_k(kA, Kb + (long)j * 64 * LD, LD, l16, q4);
#define SEL_STEP(KC, KN)                                                                                   \
    {                                                                                                      \
      int jn = j + 1;                                                                                      \
      while (jn <= tblk && __builtin_amdgcn_readfirstlane(flags[jn]) == 0u) ++jn;                          \
      if (jn <= tblk) load_k(KN, Kb + (long)jn * 64 * LD, LD, l16, q4);                                    \
      const unsigned f = __builtin_amdgcn_readfirstlane(flags[j]);                                         \
      const bool sel = (f >> q4) & 1u;                                                                     \
      bool valid[4];                                                                                       \
      _Pragma("unroll") for (int nt = 0; nt < 4; ++nt) valid[nt] = sel && (j * 64 + nt * 16 + l16 <= tme); \
      attn_block(st, qf, KC, Vb + (long)j * 4096, 64, valid, pbuf, l16, q4);                               \
      j = jn;                                                                                              \
    }
    while (j <= tblk) {
      SEL_STEP(kA, kB)
      if (j > tblk) break;
      SEL_STEP(kB, kA)
    }
#undef SEL_STEP
#pragma unroll
    for (int r = 0; r < 4; ++r) { const float lt = red16_sum(st.l[r]); const float sc = lt > 0.f ? gate[r][1] / lt : 0.f;
#pragma unroll
      for (int dt = 0; dt < 4; ++dt) y[dt][r] += sc * st.o[dt][r]; }
  }
  {
    AttnSt st;
#pragma unroll
    for (int d = 0; d < 4; ++d) st.o[d] = zero4();
#pragma unroll
    for (int r = 0; r < 4; ++r) { st.m[r] = -1e4f; st.l[r] = 0.f; }
    const u16* Kb = proj + (tokb + g * 8) * LD + C_KW;
    const u16* Vb = P.vwT + (long)bg * 128 * 4096;
    int j0 = (t0 - 511) >> 6; if (j0 < 0) j0 = 0;
    bf16x8 kA[4][2], kB[4][2];
    load_k(kA, Kb + (long)j0 * 64 * LD, LD, l16, q4);
#define WIN_STEP(KC, KN)                                                                                   \
    {                                                                                                      \
      if (j + 1 <= tblk) load_k(KN, Kb + (long)(j + 1) * 64 * LD, LD, l16, q4);                            \
      bool valid[4];                                                                                       \
      _Pragma("unroll") for (int nt = 0; nt < 4; ++nt) { const int pos = j * 64 + nt * 16 + l16; valid[nt] = (pos <= tme) && (pos > tme - 512); } \
      attn_block(st, qf, KC, Vb + (long)j * 4096, 64, valid, pbuf, l16, q4);                               \
      ++j;                                                                                                 \
    }
    int j = j0;
    while (j <= tblk) {
      WIN_STEP(kA, kB)
      if (j > tblk) break;
      WIN_STEP(kB, kA)
    }
#undef WIN_STEP
#pragma unroll
    for (int r = 0; r < 4; ++r) { const float lt = red16_sum(st.l[r]); const float sc = lt > 0.f ? gate[r][2] / lt : 0.f;
#pragma unroll
      for (int dt = 0; dt < 4; ++dt) y[dt][r] += sc * st.o[dt][r]; }
  }
  {
    u16* op = proj + (tokb + tme) * LD + C_NZ + g * 256 + l16;
#pragma unroll
    for (int r = 0; r < 4; ++r)
#pragma unroll
      for (int dt = 0; dt < 4; ++dt) { u16* e = op + r * 64 + dt * 16; const float z = bf2f(*e); *e = f2bf(y[dt][r] * siluf_(z)); }
  }
  wave_sync();
}

#define SL_RH 0
#define SL_AH 2048
#define SL_WV 4096
#define SL_UV 6144
#define SL_BK 8192
#define SL_VT 12288
#define SL_GC 14336
#define SL_BON 14592
#define SL_M1 14656
#define SL_M2 15168
#define SL_SIZE 16384

__device__ __forceinline__ void ld4s(bf16x4 a, bf16x4 p, const float* mu, float (&o)[4]) {
  float4 m = *(const float4*)mu;
  float x0 = bf2f((u16)a[0]), x1 = bf2f((u16)a[1]), x2 = bf2f((u16)a[2]), x3 = bf2f((u16)a[3]);
  o[0] = x0 + (bf2f((u16)p[0]) - x0) * m.x; o[1] = x1 + (bf2f((u16)p[1]) - x1) * m.y;
  o[2] = x2 + (bf2f((u16)p[2]) - x2) * m.z; o[3] = x3 + (bf2f((u16)p[3]) - x3) * m.w;
}

template <int PASS>
__device__ void rwkv_precompute(const Params& P, int layer, int b, int h, int c, char* sl) {
  const int lane = TIDX_f() & 63, l16 = lane & 15, q4 = lane >> 4;
  u16* RH = (u16*)(sl + SL_RH); u16* AH = (u16*)(sl + SL_AH); u16* WV = (u16*)(sl + SL_WV); u16* UV = (u16*)(sl + SL_UV);
  u16* BK = (u16*)(sl + SL_BK); u16* VT = (u16*)(sl + SL_VT); float* GC = (float*)(sl + SL_GC); float* BON = (float*)(sl + SL_BON);
  u16* M1 = (u16*)(sl + SL_M1); u16* M2 = (u16*)(sl + SL_M2);
  u16* WT1 = RH; u16* WT2 = AH; u16* WT3 = RH; float* AT = (float*)(sl + SL_WV); u16* MBM = UV;
  const long tok = (long)b * SEQ + c * 16 + l16;
  const u16* rowp = P.proj + tok * LD + C_RS;
  const u16* prevp = rowp - LD;
  const u16* tilep = P.proj + ((long)b * SEQ + c * 16) * LD + C_RS;
  const bool hasprev = !(c == 0 && l16 == 0);
  const float* mu = P.rk_mu + layer * 1664;
  const int hj = h * 64;
  bf16x4 rc[5][4], rp[5][4];
  const int poff = (l16 > 0) ? (l16 - 1) * 4 : (60 - 16 * LD);
#pragma unroll
  for (int q = 0; q < 5; ++q) {
    const int cb = (q < 3) ? (q * 512 + hj) : (1536 + (q - 3) * 64);
#pragma unroll
    for (int mt = 0; mt < 4; ++mt) {
      const u16* tp = tilep + (long)(mt * 4 + q4) * LD + cb;
      rc[q][mt] = *(const bf16x4*)(tp + l16 * 4);
      bf16x4 z = {0, 0, 0, 0};
      rp[q][mt] = hasprev ? *(const bf16x4*)(tp + poff) : z;
    }
  }
  f32x4 wacc[4], aacc[4];
  {
    float tw[16], al[16];
#pragma unroll
    for (int mt = 0; mt < 4; ++mt) {
      float t4[4];
      ld4s(rc[3][mt], rp[3][mt], mu + 1536 + 16 * mt + 4 * q4, t4);
#pragma unroll
      for (int r = 0; r < 4; ++r) tw[mt * 4 + r] = 1.f - 2.f * __builtin_amdgcn_rcpf(1.f + __expf(2.f * t4[r]));
      ld4s(rc[4][mt], rp[4][mt], mu + 1600 + 16 * mt + 4 * q4, t4);
#pragma unroll
      for (int r = 0; r < 4; ++r) al[mt * 4 + r] = t4[r];
    }
    bf16x8 twf[2], alf[2];
#pragma unroll
    for (int ks = 0; ks < 2; ++ks) {
      twf[ks] = pack8(tw[ks * 8], tw[ks * 8 + 1], tw[ks * 8 + 2], tw[ks * 8 + 3], tw[ks * 8 + 4], tw[ks * 8 + 5], tw[ks * 8 + 6], tw[ks * 8 + 7]);
      alf[ks] = pack8(al[ks * 8], al[ks * 8 + 1], al[ks * 8 + 2], al[ks * 8 + 3], al[ks * 8 + 4], al[ks * 8 + 5], al[ks * 8 + 6], al[ks * 8 + 7]);
    }
    const u16* w2 = P.w2T + ((long)(layer * 8 + h) * 8) * 512;
    const u16* a2 = P.a2T + ((long)(layer * 8 + h) * 8) * 512;
#pragma unroll
    for (int mt = 0; mt < 4; ++mt) {
      wacc[mt] = zero4(); aacc[mt] = zero4();
#pragma unroll
      for (int ks = 0; ks < 2; ++ks) {
        wacc[mt] = MFMA(*(const bf16x8*)(w2 + ((mt * 2 + ks) * 64 + lane) * 8), twf[ks], wacc[mt]);
        aacc[mt] = MFMA(*(const bf16x8*)(a2 + ((mt * 2 + ks) * 64 + lane) * 8), alf[ks], aacc[mt]);
      }
    }
  }
  __builtin_amdgcn_sched_barrier(0);
  bf16x8 Atf[2], Btf[2], Ktf[2], Rtf[2];
  Rtf[0] = zero8(); Rtf[1] = zero8();
  {
    float logd[16], alr[16], lgl[16], kk[16], km[16];
#pragma unroll
    for (int mt = 0; mt < 4; ++mt) {
      const int jo = 16 * mt + 4 * q4;
      const float4 w0 = *(const float4*)(P.rk_w0 + layer * 512 + hj + jo);
      const float4 a0 = *(const float4*)(P.rk_a0 + layer * 512 + hj + jo);
      const float w0a[4] = {w0.x, w0.y, w0.z, w0.w}, a0a[4] = {a0.x, a0.y, a0.z, a0.w};
#pragma unroll
      for (int r = 0; r < 4; ++r) {
        const int e = mt * 4 + r;
        logd[e] = -0.60653066f * sigmoidf_(w0a[r] + wacc[mt][r]);
        alr[e] = sigmoidf_(a0a[r] + aacc[mt][r]);
      }
    }
  __builtin_amdgcn_sched_barrier(0);
#pragma unroll
    for (int e = 0; e < 16; ++e) {
      float x = logd[e];
      x += __int_as_float(__builtin_amdgcn_update_dpp(0, __float_as_int(x), 0x111, 0xF, 0xF, true));
      x += __int_as_float(__builtin_amdgcn_update_dpp(0, __float_as_int(x), 0x112, 0xF, 0xF, true));
      x += __int_as_float(__builtin_amdgcn_update_dpp(0, __float_as_int(x), 0x114, 0xF, 0xF, true));
      x += __int_as_float(__builtin_amdgcn_update_dpp(0, __float_as_int(x), 0x118, 0xF, 0xF, true));
      lgl[e] = x;
    }
    if (l16 == 15) {
#pragma unroll
      for (int mt = 0; mt < 4; ++mt) *(float4*)(GC + 16 * mt + 4 * q4) = make_float4(__expf(lgl[mt * 4]), __expf(lgl[mt * 4 + 1]), __expf(lgl[mt * 4 + 2]), __expf(lgl[mt * 4 + 3]));
    }
    wave_sync();
  __builtin_amdgcn_sched_barrier(0);
    float n2 = 0.f;
#pragma unroll
    for (int mt = 0; mt < 4; ++mt) {
      const int jo = 16 * mt + 4 * q4;
      float t4[4];
      ld4s(rc[1][mt], rp[1][mt], mu + 512 + hj + jo, t4);
      const float4 kkw = *(const float4*)(P.rk_kk + layer * 512 + hj + jo);
      const float4 kaw = *(const float4*)(P.rk_ka + layer * 512 + hj + jo);
      const float kka[4] = {kkw.x, kkw.y, kkw.z, kkw.w}, kaa[4] = {kaw.x, kaw.y, kaw.z, kaw.w};
#pragma unroll
      for (int r = 0; r < 4; ++r) {
        const int e = mt * 4 + r;
        const float kf = t4[r] * kka[r];
        kk[e] = kf; n2 += kf * kf;
        km[e] = t4[r] * (1.f + (alr[e] - 1.f) * kaa[r]);
      }
    }
    n2 += shx(n2, 16); n2 += shx(n2, 32);
    const float inv = __builtin_amdgcn_rsqf(fmaxf(n2, 1e-24f));
  __builtin_amdgcn_sched_barrier(0);
    float bon = 0.f;
    {
      float At[16], Bt[16], Kt[16];
#pragma unroll
      for (int e = 0; e < 16; ++e) {
        const float lg = lgl[e];
        const float kkn = kk[e] * inv;
        const float ieg = __expf(-lg), egm = __expf(lg - logd[e]), eC = GC[16 * (e >> 2) + 4 * q4 + (e & 3)] * ieg;
        const float bb = kkn * alr[e];
        At[e] = -kkn * egm; Bt[e] = bb * ieg; Kt[e] = km[e] * ieg;
        {
          const int j = 16 * (e >> 2) + 4 * q4 + (e & 3);
          u16* bp = BK + j * 32 + (l16 >> 2) * 8 + (l16 & 3);
          bp[0] = f2bf(bb * eC); bp[4] = f2bf(km[e] * eC);
        }
      }
#pragma unroll
      for (int ks = 0; ks < 2; ++ks) {
        Atf[ks] = pack8(At[ks * 8], At[ks * 8 + 1], At[ks * 8 + 2], At[ks * 8 + 3], At[ks * 8 + 4], At[ks * 8 + 5], At[ks * 8 + 6], At[ks * 8 + 7]);
        Btf[ks] = pack8(Bt[ks * 8], Bt[ks * 8 + 1], Bt[ks * 8 + 2], Bt[ks * 8 + 3], Bt[ks * 8 + 4], Bt[ks * 8 + 5], Bt[ks * 8 + 6], Bt[ks * 8 + 7]);
        Ktf[ks] = pack8(Kt[ks * 8], Kt[ks * 8 + 1], Kt[ks * 8 + 2], Kt[ks * 8 + 3], Kt[ks * 8 + 4], Kt[ks * 8 + 5], Kt[ks * 8 + 6], Kt[ks * 8 + 7]);
      }
    }
#pragma unroll
    for (int mt = 0; mt < 4; ++mt) {
      const int jo = 16 * mt + 4 * q4;
      float t4[4];
      if (PASS == 2) {
        ld4s(rc[0][mt], rp[0][mt], mu + hj + jo, t4);
        const float4 rkw = *(const float4*)(P.rk_rk + layer * 512 + hj + jo);
        const float rka[4] = {rkw.x, rkw.y, rkw.z, rkw.w};
        float rt[4];
#pragma unroll
        for (int r = 0; r < 4; ++r) { const int e = mt * 4 + r; bon += t4[r] * km[e] * rka[r]; rt[r] = t4[r] * __expf(lgl[e]); }
#pragma unroll
        for (int r = 0; r < 4; ++r) Rtf[mt >> 1][(mt & 1) * 4 + r] = (short)f2bf(rt[r]);
      }
      ld4s(rc[2][mt], rp[2][mt], mu + 1024 + hj + jo, t4);
#pragma unroll
      for (int r = 0; r < 4; ++r) VT[(jo + r) * 16 + l16] = f2bf(t4[r]);
    }
    bon += shx(bon, 16); bon += shx(bon, 32);
    if (q4 == 0) BON[l16] = bon;
#pragma unroll
    for (int e = 0; e < 16; ++e) { const int j = 16 * (e >> 2) + 4 * q4 + (e & 3); WT1[j * 16 + l16] = (u16)Atf[e >> 3][e & 7]; }
  }
  __builtin_amdgcn_sched_barrier(0);
  f32x4 Am = MFMA(Atf[0], Btf[0], zero4()); Am = MFMA(Atf[1], Btf[1], Am);
  f32x4 Bm = MFMA(Atf[0], Ktf[0], zero4()); Bm = MFMA(Atf[1], Ktf[1], Bm);
  f32x4 Pm = zero4(), Qm = zero4();
  if (PASS == 2) {
    Pm = MFMA(Rtf[0], Btf[0], zero4()); Pm = MFMA(Rtf[1], Btf[1], Pm);
    Qm = MFMA(Rtf[0], Ktf[0], zero4()); Qm = MFMA(Rtf[1], Ktf[1], Qm);
  }
#pragma unroll
  for (int r = 0; r < 4; ++r) {
    const int t = 4 * q4 + r;
    if (!(l16 < t)) { Am[r] = 0.f; Bm[r] = 0.f; }
    if (!(l16 <= t)) { Pm[r] = 0.f; Qm[r] = 0.f; }
  }
  __builtin_amdgcn_sched_barrier(0);
  *(float4*)(AT + l16 * 16 + 4 * q4) = make_float4(Am[0], Am[1], Am[2], Am[3]);
#pragma unroll
  for (int r = 0; r < 4; ++r) {
    MBM[(4 * q4 + r) * 16 + l16] = f2bf(Bm[r]);
    if (PASS == 2) { M2[(4 * q4 + r) * 32 + l16] = f2bf(Pm[r]); M2[(4 * q4 + r) * 32 + 16 + l16] = f2bf(Qm[r]); }
  }
  wave_sync();
  {
    float xv[16];
#pragma unroll
    for (int t = 0; t < 16; ++t) xv[t] = (t == l16) ? 1.f : 0.f;
#pragma unroll
    for (int s = 0; s < 15; ++s) {
      const float xs = xv[s];
#pragma unroll
      for (int t = s + 1; t < 16; ++t) xv[t] += AT[s * 16 + t] * xs;
    }
#pragma unroll
    for (int t = 0; t < 16; ++t) if ((t >> 2) == q4) M1[t * 16 + l16] = f2bf(xv[t]);
  }
  wave_sync();
  const bf16x4 Tf = *(const bf16x4*)(M1 + l16 * 16 + q4 * 4);
  __builtin_amdgcn_sched_barrier(0);
  unsigned Apk[8], Rpk[8] = {0u, 0u, 0u, 0u, 0u, 0u, 0u, 0u};
  {
    f32x4 Ahp[4];
#pragma unroll
    for (int mt = 0; mt < 4; ++mt) { bf16x4 af = *(const bf16x4*)(WT1 + (16 * mt + l16) * 16 + q4 * 4); Ahp[mt] = MFMA16(af, Tf, zero4()); }
#pragma unroll
    for (int mt = 0; mt < 4; ++mt) { Apk[mt * 2] = pack2(Ahp[mt][0], Ahp[mt][1]); Apk[mt * 2 + 1] = pack2(Ahp[mt][2], Ahp[mt][3]); }
  }
  __builtin_amdgcn_sched_barrier(0);
  if (PASS == 2) {
#pragma unroll
  for (int e = 0; e < 16; ++e) { const int j = 16 * (e >> 2) + 4 * q4 + (e & 3); WT1[j * 16 + l16] = (u16)((Apk[e >> 1] >> ((e & 1) * 16)) & 0xffffu); }
  wave_sync();
  {
    const bf16x4 Pf = *(const bf16x4*)(M2 + l16 * 32 + q4 * 4);
#pragma unroll
    for (int mt = 0; mt < 4; ++mt) {
      bf16x4 af = *(const bf16x4*)(WT1 + (16 * mt + l16) * 16 + q4 * 4);
      f32x4 ci;
#pragma unroll
      for (int r = 0; r < 4; ++r) ci[r] = bf2f((u16)Rtf[mt >> 1][(mt & 1) * 4 + r]);
      f32x4 rh = MFMA16(af, Pf, ci);
      Rpk[mt * 2] = pack2(rh[0], rh[1]); Rpk[mt * 2 + 1] = pack2(rh[2], rh[3]);
    }
  }
  }
  __builtin_amdgcn_sched_barrier(0);
  {
    const bf16x4 Bmf = *(const bf16x4*)(MBM + l16 * 16 + q4 * 4);
    f32x4 BVp[4];
#pragma unroll
    for (int mt = 0; mt < 4; ++mt) { bf16x4 af = *(const bf16x4*)(VT + (16 * mt + l16) * 16 + q4 * 4); BVp[mt] = MFMA16(af, Bmf, zero4()); }
    wave_sync();
#pragma unroll
    for (int e = 0; e < 16; ++e) { const int i = 16 * (e >> 2) + 4 * q4 + (e & 3); WT2[i * 16 + l16] = f2bf(BVp[e >> 2][e & 3]); }
    wave_sync();
    f32x4 uv[4];
#pragma unroll
    for (int nt = 0; nt < 4; ++nt) { bf16x4 bf = *(const bf16x4*)(WT2 + (16 * nt + l16) * 16 + q4 * 4); uv[nt] = MFMA16(Tf, bf, zero4()); }
    wave_sync();
#pragma unroll
    for (int nt = 0; nt < 4; ++nt) {
#pragma unroll
      for (int r = 0; r < 4; ++r) UV[(nt * 4 + r) * 64 + lane] = f2bf(uv[nt][r]);
      if (PASS == 2) {
        const int i = 16 * nt + l16;
        uint2 o; o.x = pack2(uv[nt][0], uv[nt][1]); o.y = pack2(uv[nt][2], uv[nt][3]);
        *(uint2*)(WT3 + i * 32 + 4 * q4) = o;
        *(uint2*)(WT3 + i * 32 + 16 + 4 * q4) = *(const uint2*)(VT + i * 16 + 4 * q4);
      }
    }
  }
  __builtin_amdgcn_sched_barrier(0);
  wave_sync();
  if (PASS == 2) {
    const bf16x8 PQf = *(const bf16x8*)(M2 + l16 * 32 + q4 * 8);
    f32x4 wv[4];
#pragma unroll
    for (int nt = 0; nt < 4; ++nt) { bf16x8 bf = *(const bf16x8*)(WT3 + (16 * nt + l16) * 32 + q4 * 8); wv[nt] = MFMA(PQf, bf, zero4()); }
    wave_sync();
#pragma unroll
    for (int nt = 0; nt < 4; ++nt)
#pragma unroll
      for (int r = 0; r < 4; ++r) WV[(nt * 4 + r) * 64 + lane] = f2bf(wv[nt][r]);
  }
  __builtin_amdgcn_sched_barrier(0);
  {
    if (PASS == 2) {
      *(uint4*)(RH + (l16 * 4 + q4) * 16) = make_uint4(Rpk[0], Rpk[1], Rpk[2], Rpk[3]);
      *(uint4*)(RH + (l16 * 4 + q4) * 16 + 8) = make_uint4(Rpk[4], Rpk[5], Rpk[6], Rpk[7]);
    }
    *(uint4*)(AH + (l16 * 4 + q4) * 16) = make_uint4(Apk[0], Apk[1], Apk[2], Apk[3]);
    *(uint4*)(AH + (l16 * 4 + q4) * 16 + 8) = make_uint4(Apk[4], Apk[5], Apk[6], Apk[7]);
  }
}

template <int PASS>
__device__ void rwkv_seg(const Params& P, int layer, int chain, int seg, char* lds) {
  const int tid = TIDX_f(), lane = tid & 63, w = tid >> 6, l16 = lane & 15, q4 = lane >> 4;
  const int b = chain >> 3, h = chain & 7;
  f32x4 ST[4], ET[4];
#pragma unroll
  for (int i = 0; i < 4; ++i) { ST[i] = zero4(); ET[i] = zero4(); }
  const int ich = h * 64 + 16 * w + l16;
  const float lnG = P.rk_lnx_g[layer * 512 + ich], lnB = P.rk_lnx_b[layer * 512 + ich];
  __syncthreads();
  if (PASS == 1) {
#pragma unroll
    for (int nt = 0; nt < 4; ++nt)
#pragma unroll
      for (int r = 0; r < 4; ++r) ET[nt][r] = ((16 * nt + 4 * q4 + r) == (16 * w + l16)) ? 1.f : 0.f;
  } else if (seg > 0) {
    float* Sa = (float*)lds; float* Sb = Sa + 4096; float* Mb = Sb + 4096;
    const int i = tid >> 2, jq = tid & 3;
    for (int e = tid; e < 4096; e += 256) Sa[e] = 0.f;
    for (int s = 0; s < seg; ++s) {
      const float* G = P.mg + ((long)(chain * 8 + s) * 2) * 4096; const float* M = G + 4096;
      __syncthreads();
      for (int e = tid; e < 1024; e += 256) *(float4*)(Mb + e * 4) = *(const float4*)(M + e * 4);
      float acc[16];
#pragma unroll
      for (int q = 0; q < 4; ++q) { float4 g4 = *(const float4*)(G + i * 64 + jq * 16 + q * 4); acc[q * 4] = g4.x; acc[q * 4 + 1] = g4.y; acc[q * 4 + 2] = g4.z; acc[q * 4 + 3] = g4.w; }
      __syncthreads();
      for (int k = 0; k < 64; ++k) {
        const float sik = Sa[i * 64 + k];
#pragma unroll
        for (int q = 0; q < 4; ++q) { float4 m4 = *(const float4*)(Mb + k * 64 + jq * 16 + q * 4); acc[q * 4] += sik * m4.x; acc[q * 4 + 1] += sik * m4.y; acc[q * 4 + 2] += sik * m4.z; acc[q * 4 + 3] += sik * m4.w; }
      }
#pragma unroll
      for (int q = 0; q < 4; ++q) *(float4*)(Sb + i * 64 + jq * 16 + q * 4) = make_float4(acc[q * 4], acc[q * 4 + 1], acc[q * 4 + 2], acc[q * 4 + 3]);
      float* t = Sa; Sa = Sb; Sb = t;
    }
    __syncthreads();
#pragma unroll
    for (int nt = 0; nt < 4; ++nt) { float4 v = *(const float4*)(Sa + (16 * w + l16) * 64 + 16 * nt + 4 * q4); ST[nt][0] = v.x; ST[nt][1] = v.y; ST[nt][2] = v.z; ST[nt][3] = v.w; }
  }
  for (int rd = seg * 16; rd < seg * 16 + 16; ++rd) {
    __syncthreads();
    rwkv_precompute<PASS>(P, layer, b, h, rd * 4 + w, lds + w * SL_SIZE);
    __syncthreads();
    unsigned touch0 = 0, touch1 = 0;
    if (rd + 1 < seg * 16 + 16) {
      const u16* base = P.proj + ((long)b * SEQ + ((rd + 1) * 4 + w) * 16 - 1) * LD + C_RS;
      { const int id = lane; const int row = id / 5, q = id - row * 5; const int cb = (q < 3) ? (q * 512 + h * 64) : (1536 + (q - 3) * 64);
        touch0 = *(const volatile unsigned*)(base + (long)row * LD + cb); }
      if (lane + 64 < 85) { const int id = lane + 64; const int row = id / 5, q = id - row * 5; const int cb = (q < 3) ? (q * 512 + h * 64) : (1536 + (q - 3) * 64);
        touch1 = *(const volatile unsigned*)(base + (long)row * LD + cb); }
    }
    f32x4 Y[4];
#pragma unroll
    for (int cc = 0; cc < 4; ++cc) {
      const char* sl = lds + cc * SL_SIZE;
      const u16* RH = (const u16*)(sl + SL_RH); const u16* AH = (const u16*)(sl + SL_AH); const u16* WV = (const u16*)(sl + SL_WV); const u16* UV = (const u16*)(sl + SL_UV);
      const u16* BK = (const u16*)(sl + SL_BK); const u16* VT = (const u16*)(sl + SL_VT); const float* GC = (const float*)(sl + SL_GC);
      bf16x8 sop[2];
      sop[0] = pack8(ST[0][0], ST[0][1], ST[0][2], ST[0][3], ST[1][0], ST[1][1], ST[1][2], ST[1][3]);
      sop[1] = pack8(ST[2][0], ST[2][1], ST[2][2], ST[2][3], ST[3][0], ST[3][1], ST[3][2], ST[3][3]);
      const bf16x8 af0 = *(const bf16x8*)(AH + (l16 * 4 + q4) * 16), af1 = *(const bf16x8*)(AH + (l16 * 4 + q4) * 16 + 8);
      f32x4 ua;
#pragma unroll
      for (int r = 0; r < 4; ++r) ua[r] = bf2f(UV[(w * 4 + r) * 64 + lane]);
      ua = MFMA(af0, sop[0], ua); ua = MFMA(af1, sop[1], ua);
      if (PASS == 2) {
        f32x4 ya;
#pragma unroll
        for (int r = 0; r < 4; ++r) ya[r] = bf2f(WV[(w * 4 + r) * 64 + lane]);
        ya = MFMA(*(const bf16x8*)(RH + (l16 * 4 + q4) * 16), sop[0], ya);
        ya = MFMA(*(const bf16x8*)(RH + (l16 * 4 + q4) * 16 + 8), sop[1], ya);
        Y[cc] = ya;
      }
      bf16x4 v4 = *(const bf16x4*)(VT + (16 * w + l16) * 16 + 4 * q4);
      u32x4_t bt = {pack2(ua[0], ua[1]), pack2(ua[2], ua[3]), 0u, 0u};
      bf16x8 bop = __builtin_bit_cast(bf16x8, bt);
      bop[4] = v4[0]; bop[5] = v4[1]; bop[6] = v4[2]; bop[7] = v4[3];
      bf16x8 bope = zero8();
      if (PASS == 1) {
        bf16x8 eop0 = pack8(ET[0][0], ET[0][1], ET[0][2], ET[0][3], ET[1][0], ET[1][1], ET[1][2], ET[1][3]);
        bf16x8 eop1 = pack8(ET[2][0], ET[2][1], ET[2][2], ET[2][3], ET[3][0], ET[3][1], ET[3][2], ET[3][3]);
        f32x4 xe = MFMA(af0, eop0, zero4()); xe = MFMA(af1, eop1, xe);
        u32x4_t et = {pack2(xe[0], xe[1]), pack2(xe[2], xe[3]), 0u, 0u};
        bope = __builtin_bit_cast(bf16x8, et);
      }
#pragma unroll
      for (int nt = 0; nt < 4; ++nt) {
        const float4 g4 = *(const float4*)(GC + 16 * nt + 4 * q4);
        const bf16x8 bkf = *(const bf16x8*)(BK + (16 * nt + l16) * 32 + q4 * 8);
        f32x4 ci = {ST[nt][0] * g4.x, ST[nt][1] * g4.y, ST[nt][2] * g4.z, ST[nt][3] * g4.w};
        ST[nt] = MFMA(bkf, bop, ci);
        if (PASS == 1) {
          f32x4 ce = {ET[nt][0] * g4.x, ET[nt][1] * g4.y, ET[nt][2] * g4.z, ET[nt][3] * g4.w};
          ET[nt] = MFMA(bkf, bope, ce);
        }
      }
    }
    if (PASS == 2) {
#pragma unroll
      for (int cc = 0; cc < 4; ++cc) {
        float* stt = (float*)(lds + cc * SL_SIZE + SL_M2);
#pragma unroll
        for (int r = 0; r < 4; ++r) {
          float s1 = red16_sum(Y[cc][r]), s2 = red16_sum(Y[cc][r] * Y[cc][r]);
          if (l16 == 0) { stt[(w * 16 + 4 * q4 + r) * 2] = s1; stt[(w * 16 + 4 * q4 + r) * 2 + 1] = s2; }
        }
      }
      __syncthreads();
#pragma unroll
      for (int cc = 0; cc < 4; ++cc) {
        const char* sl = lds + cc * SL_SIZE;
        const float* stt = (const float*)(sl + SL_M2); const float* BON = (const float*)(sl + SL_BON); const u16* VT = (const u16*)(sl + SL_VT);
        bf16x4 v4 = *(const bf16x4*)(VT + (16 * w + l16) * 16 + 4 * q4);
#pragma unroll
        for (int r = 0; r < 4; ++r) {
          const int t = 4 * q4 + r;
          float s1 = 0.f, s2 = 0.f;
#pragma unroll
          for (int ww = 0; ww < 4; ++ww) { s1 += stt[(ww * 16 + t) * 2]; s2 += stt[(ww * 16 + t) * 2 + 1]; }
          const float mean = s1 * (1.f / 64.f), var = fmaxf(s2 * (1.f / 64.f) - mean * mean, 0.f);
          const float yn = (Y[cc][r] - mean) * rsqrtf(var + 64e-5f) * lnG + lnB + BON[t] * bf2f((u16)v4[r]);
          u16* op = P.proj + ((long)b * SEQ + (rd * 4 + cc) * 16 + t) * LD + C_RZ + ich;
          const float z = bf2f(*op);
          *op = f2bf(yn * siluf_(z));
        }
      }
    }
    asm volatile("" ::"v"(touch0), "v"(touch1));
  }
  if (PASS == 1) {
    float* G = P.mg + ((long)(chain * 8 + seg) * 2) * 4096; float* M = G + 4096;
#pragma unroll
    for (int nt = 0; nt < 4; ++nt) {
      *(float4*)(G + (16 * w + l16) * 64 + 16 * nt + 4 * q4) = make_float4(ST[nt][0], ST[nt][1], ST[nt][2], ST[nt][3]);
      *(float4*)(M + (16 * w + l16) * 64 + 16 * nt + 4 * q4) = make_float4(ET[nt][0], ET[nt][1], ET[nt][2], ET[nt][3]);
    }
  }
  __syncthreads();
}

__device__ void phase_mid1(const Params& P, int layer, char* lds) {
  const int gw = BIDX_f() * 4 + (TIDX_f() >> 6), nw = gridDim.x * 4;
  for (int i = BIDX_f() * 256 + TIDX_f(); i < TOK; i += gridDim.x * 256) P.rstd2[i] = 0.f;
  for (int it = gw; it < 1024; it += nw) compress_item(P, layer, it);
  for (int it = BIDX_f(); it < 2048; it += gridDim.x) sgprep_item(P, layer, it, lds);
}

__device__ void phase_mid2(const Params& P, int layer, char* lds, int* s_item) {
  for (int task = BIDX_f(); task < 512; task += gridDim.x) rwkv_seg<2>(P, layer, task >> 3, task & 7, lds);
  const int w = TIDX_f() >> 6;
  int* ctr = P.ctr + layer;
  for (;;) {
    __syncthreads();
    if (TIDX_f() == 0) *s_item = atomicAdd(ctr, 1);
    __syncthreads();
    const int it = *s_item;
    if (it >= 8192 + 4096) break;
    if (it < 8192) nsa_item(P, it * 4 + w, lds + w * 11008);
    else sg_item(P, layer, (it - 8192) * 4 + w);
  }
}

__global__ void __launch_bounds__(256, 2) mega(Params P) {
  __shared__ __attribute__((aligned(16))) char lds[65536];
  __shared__ int s_item;
  phase_weights(P, lds);
  phase_rstd(P.x, P.rstd, P.hb, false);
  cg::this_grid().sync();
  for (int layer = 0; layer < 2; ++layer) {
    const float* xin = layer == 0 ? P.x : P.out;
    phase_inproj(P, layer, xin, lds);
    cg::this_grid().sync();
    phase_mid1(P, layer, lds);
    cg::this_grid().sync();
    for (int task = BIDX_f(); task < 448; task += gridDim.x) rwkv_seg<1>(P, layer, task / 7, task % 7, lds);
    cg::this_grid().sync();
    phase_mid2(P, layer, lds, &s_item);
    cg::this_grid().sync();
    phase_merge(P, layer, xin, lds);
    cg::this_grid().sync();
    phase_wo(P, layer, xin, P.out, lds);
    cg::this_grid().sync();
    phase_ple(P, layer, P.out, lds);
    cg::this_grid().sync();
    if (layer == 0) { phase_rstd(P.out, P.rstd, P.hb, false); cg::this_grid().sync(); }
  }
  phase_final_norm(P.out, P.final_norm_g);
}

extern "C" void kernel_launch(void* const* d_in, const int* in_sizes, int n_in, void* d_out, int out_size, void* d_ws, size_t ws_size, hipStream_t stream) {
  static int grid_blocks = 0;
  if (!grid_blocks) {
    int dev = 0, cus = 0, per_cu = 0;
    hipGetDevice(&dev);
    hipDeviceGetAttribute(&cus, hipDeviceAttributeMultiprocessorCount, dev);
    hipOccupancyMaxActiveBlocksPerMultiprocessor(&per_cu, (const void*)mega, 256, 0);
    if (per_cu < 1) per_cu = 1;
    if (per_cu > 2) per_cu = 2;
    grid_blocks = (cus * per_cu) & ~7;
    if (grid_blocks < 8) grid_blocks = 8;
  }
  Params P{};
  const float** pf = (const float**)&P;
  for (int i = 0; i < 27; ++i) pf[i] = (const float*)d_in[i];
  P.out = (float*)d_out;
  char* ws = (char*)d_ws; size_t off = 0;
  auto take = [&](size_t bytes) { char* p = ws + off; off += (bytes + 255) & ~(size_t)255; return p; };
  P.WinT = (u16*)take((size_t)2 * LD * 1024 * 2);
  P.WmgT = (u16*)take((size_t)2 * 3072 * 1024 * 2);
  P.WbrT = (u16*)take((size_t)2 * 3 * 1024 * 512 * 2);
  P.WoT = (u16*)take((size_t)2 * 1024 * 1024 * 2);
  P.WgT = (u16*)take((size_t)2 * 1024 * 1024 * 2);
  P.WpT = (u16*)take((size_t)2 * 1024 * 256 * 2);
  P.W1T = (u16*)take((size_t)4 * 128 * 2048 * 2);
  P.W2T = (u16*)take((size_t)4 * 64 * 128 * 2);
  P.sgW = (u16*)take((size_t)2 * 8 * 128 * 128 * 2);
  P.w2T = (u16*)take((size_t)2 * 512 * 64 * 2);
  P.a2T = (u16*)take((size_t)2 * 512 * 64 * 2);
  P.kc = (u16*)take((size_t)16 * 512 * 64 * 2);
  P.vcT = (u16*)take((size_t)16 * 64 * 512 * 2);
  P.vsT = (u16*)take((size_t)16 * 64 * SEQ * 2);
  P.vwT = (u16*)take((size_t)16 * 64 * SEQ * 2);
  P.vnT = (u16*)take((size_t)8 * 512 * SEQ * 2);
  P.proj = (u16*)take((size_t)TOK * LD * 2);
  P.hb = (u16*)take((size_t)TOK * 1024 * 2);
  P.c1 = (float*)take(512 * 4);
  P.rstd = (float*)take((size_t)TOK * 4);
  P.rstd2 = (float*)take((size_t)TOK * 4);
  P.mg = (float*)take((size_t)64 * 8 * 2 * 4096 * 4);
  P.ctr = (int*)take(256);
  if (off > ws_size) { fprintf(stderr, "workspace too small: need %zu have %zu\n", off, ws_size); return; }
  void* args[] = {&P};
  hipError_t e = hipLaunchCooperativeKernel((const void*)mega, dim3(grid_blocks), dim3(256), args, 0, stream);
  if (e != hipSuccess) fprintf(stderr, "cooperative launch failed: %s (grid %d)\n", hipGetErrorString(e), grid_blocks);
}
```

```cpp
#include <hip/hip_runtime.h>
#include <hip/hip_bf16.h>
#include <hip/hip_cooperative_groups.h>
#include <cstdio>
namespace cg = cooperative_groups;

typedef unsigned short u16;
using bf16x8 = __attribute__((ext_vector_type(8))) short;
using bf16x4 = __attribute__((ext_vector_type(4))) short;
using f32x4 = __attribute__((ext_vector_type(4))) float;

#define TOK 65536
#define SEQ 8192
#define LD 5632
#define C_Q 0
#define C_KC 512
#define C_VC 640
#define C_KS 768
#define C_KW 1024
#define C_NZ 1280
#define C_SU 1792
#define C_SV 2304
#define C_SZ 2816
#define C_RS 3328
#define C_RZ 4992
#define C_NG 5504
#define C_MS 3328

struct Params {
  const float *x, *p, *norm_g, *w_in, *cmp_w1, *cmp_w2, *cmp_pe, *sg_ln_g, *sg_ln_b, *sg_w, *sg_b,
      *rk_mu, *rk_w0, *rk_w2, *rk_a0, *rk_a2, *rk_kk, *rk_ka, *rk_rk, *rk_lnx_g, *rk_lnx_b,
      *w_branch, *w_o, *ple_norm_g, *w_ple_gate, *w_ple_proj, *final_norm_g;
  float* out;
  u16 *WinT, *WmgT, *WbrT, *WoT, *WgT, *WpT, *W1T, *W2T, *sgW, *w2T, *a2T, *kc, *vcT, *vsT, *vwT, *vnT, *proj, *hb;
  float *c1, *rstd, *rstd2, *mg;
  int* ctr;
};

__device__ __forceinline__ int TIDX_f() { int t = threadIdx.x; asm volatile("" : "+v"(t)); return t; }
__device__ __forceinline__ int BIDX_f() { int t = blockIdx.x; asm volatile("" : "+s"(t)); return t; }
typedef __bf16 hwbf2_t __attribute__((ext_vector_type(2)));
typedef float hwf2_t __attribute__((ext_vector_type(2)));
typedef unsigned u32x4_t __attribute__((ext_vector_type(4)));
__device__ __forceinline__ unsigned pack2(float a, float b) { hwf2_t v = {a, b}; hwbf2_t r = __builtin_convertvector(v, hwbf2_t); return __builtin_bit_cast(unsigned, r); }
__device__ __forceinline__ u16 f2bf(float f) { return (u16)(pack2(f, 0.f) & 0xffffu); }
__device__ __forceinline__ float bf2f(u16 h) { return __uint_as_float(((unsigned)h) << 16); }
__device__ __forceinline__ float sigmoidf_(float x) { return __builtin_amdgcn_rcpf(1.f + __expf(-x)); }
__device__ __forceinline__ float siluf_(float x) { return x * __builtin_amdgcn_rcpf(1.f + __expf(-x)); }
__device__ __forceinline__ float shx(float v, int m) { const int l = TIDX_f() & 63; return __int_as_float(__builtin_amdgcn_ds_bpermute((l ^ m) << 2, __float_as_int(v))); }
__device__ __forceinline__ int shx(int v, int m) { const int l = TIDX_f() & 63; return __builtin_amdgcn_ds_bpermute((l ^ m) << 2, v); }
__device__ __forceinline__ float sh15(float v) { const int l = TIDX_f() & 63; return __int_as_float(__builtin_amdgcn_ds_bpermute(((l & 48) | 15) << 2, __float_as_int(v))); }
__device__ __forceinline__ void wave_sync() {
  __builtin_amdgcn_fence(__ATOMIC_RELEASE, "wavefront");
  __builtin_amdgcn_wave_barrier();
  __builtin_amdgcn_fence(__ATOMIC_ACQUIRE, "wavefront");
}
#define MFMA(a, b, c) __builtin_amdgcn_mfma_f32_16x16x32_bf16((a), (b), (c), 0, 0, 0)
#define MFMA16(a, b, c) __builtin_amdgcn_mfma_f32_16x16x16bf16_1k((a), (b), (c), 0, 0, 0)
__device__ __forceinline__ bf16x8 pack8(float a0, float a1, float a2, float a3, float a4, float a5, float a6, float a7) {
  u32x4_t t = {pack2(a0, a1), pack2(a2, a3), pack2(a4, a5), pack2(a6, a7)};
  return __builtin_bit_cast(bf16x8, t);
}
__device__ __forceinline__ bf16x8 cat44(bf16x4 a, bf16x4 b) { bf16x8 r; r[0]=a[0]; r[1]=a[1]; r[2]=a[2]; r[3]=a[3]; r[4]=b[0]; r[5]=b[1]; r[6]=b[2]; r[7]=b[3]; return r; }
__device__ __forceinline__ bf16x8 zero8() { bf16x8 r = {0,0,0,0,0,0,0,0}; return r; }
__device__ __forceinline__ f32x4 zero4() { f32x4 r = {0.f,0.f,0.f,0.f}; return r; }
#define DPPF(v, ctrl) __int_as_float(__builtin_amdgcn_mov_dpp(__float_as_int(v), (ctrl), 0xF, 0xF, true))
__device__ __forceinline__ float red16_max(float v) { v = fmaxf(v, DPPF(v, 0xB1)); v = fmaxf(v, DPPF(v, 0x4E)); v = fmaxf(v, DPPF(v, 0x141)); v = fmaxf(v, DPPF(v, 0x140)); return v; }
__device__ __forceinline__ float red16_sum(float v) { v += DPPF(v, 0xB1); v += DPPF(v, 0x4E); v += DPPF(v, 0x141); v += DPPF(v, 0x140); return v; }

template <int MODE>
__device__ void tr_conv(const float* __restrict__ src, long sld, u16* __restrict__ dst, long dld, int K, int N, const float* __restrict__ scale, float* tile) {
  const int tk = K / 64, tn = N / 64;
  const int c = TIDX_f() & 63, r4 = TIDX_f() >> 6;
  for (int t = BIDX_f(); t < tk * tn; t += gridDim.x) {
    const int k0 = (t % tk) * 64, n0 = (t / tk) * 64;
    __syncthreads();
    int n = n0 + c, sc = n; bool ok = true;
    if (MODE == 1) { if (n < 1280) sc = n; else if (n < 5504) sc = n + 24; else if (n < 5528) sc = 1280 + (n - 5504); else ok = false; }
#pragma unroll 4
    for (int r = 0; r < 16; ++r) { int kk = r4 + 4 * r; float v = ok ? src[(long)(k0 + kk) * sld + sc] : 0.f; if (scale) v *= scale[k0 + kk]; tile[kk * 65 + c] = v; }
    __syncthreads();
#pragma unroll 4
    for (int r = 0; r < 16; ++r) { int nn = r4 + 4 * r; dst[(long)(n0 + nn) * dld + k0 + c] = f2bf(tile[c * 65 + nn]); }
  }
}

__device__ void phase_weights(const Params& P, char* lds) {
  float* tile = (float*)lds;
  const int gt = BIDX_f() * 256 + TIDX_f(), ngt = gridDim.x * 256;
  if (gt < 4) P.ctr[gt] = 0;
  for (int l = 0; l < 2; ++l) {
    tr_conv<1>(P.w_in + (long)l * 1024 * 9112, 9112, P.WinT + (long)l * LD * 1024, 1024, 1024, LD, P.norm_g + l * 1024, tile);
    tr_conv<0>(P.w_in + (long)l * 1024 * 9112 + 5528, 9112, P.WmgT + (long)l * 3072 * 1024, 1024, 1024, 3072, P.norm_g + l * 1024, tile);
    for (int n = 0; n < 3; ++n)
      tr_conv<0>(P.w_branch + (long)(l * 3 + n) * 512 * 1024, 1024, P.WbrT + (long)(l * 3 + n) * 1024 * 512, 512, 512, 1024, nullptr, tile);
    tr_conv<0>(P.w_o + (long)l * 1024 * 1024, 1024, P.WoT + (long)l * 1024 * 1024, 1024, 1024, 1024, nullptr, tile);
    tr_conv<0>(P.w_ple_gate + (long)l * 1024 * 1024, 1024, P.WgT + (long)l * 1024 * 1024, 1024, 1024, 1024, P.ple_norm_g + l * 1024, tile);
    tr_conv<0>(P.w_ple_proj + (long)l * 256 * 1024, 1024, P.WpT + (long)l * 1024 * 256, 256, 256, 1024, nullptr, tile);
    for (int kv = 0; kv < 2; ++kv) {
      tr_conv<0>(P.cmp_w1 + (long)(l * 2 + kv) * 2048 * 128, 128, P.W1T + (long)(l * 2 + kv) * 128 * 2048, 2048, 2048, 128, nullptr, tile);
      tr_conv<0>(P.cmp_w2 + (long)(l * 2 + kv) * 128 * 64, 64, P.W2T + (long)(l * 2 + kv) * 64 * 128, 128, 128, 64, nullptr, tile);
    }
    for (int i = BIDX_f() * 256 + TIDX_f(); i < 64 * 512; i += gridDim.x * 256) {
      const int jg = i & 511, m = i >> 9;
      const int h = jg >> 6, mt = (jg >> 4) & 3, j16 = jg & 15, ks = m >> 5, mm = m & 31;
      const int di = (((l * 8 + h) * 4 + mt) * 2 + ks) * 512 + (((mm >> 2) & 3) * 16 + j16) * 8 + (mm >> 4) * 4 + (mm & 3);
      P.w2T[di] = f2bf(P.rk_w2[(long)l * 64 * 512 + i]);
      P.a2T[di] = f2bf(P.rk_a2[(long)l * 64 * 512 + i]);
    }
  }
  for (int i = gt; i < 2 * 8 * 128 * 128; i += ngt) {
    const int s = i & 127, t = (i >> 7) & 127, lg = i >> 14;
    const int di = ((lg * 8 + (t >> 4)) * 4 + (s >> 5)) * 512 + (((s >> 3) & 3) * 16 + (t & 15)) * 8 + (s & 7);
    P.sgW[di] = (s <= t) ? f2bf(P.sg_w[i]) : (u16)0;
  }
  {
    const int lane_ = TIDX_f() & 63, gw_ = BIDX_f() * 4 + (TIDX_f() >> 6), nw_ = gridDim.x * 4;
    for (int o = gw_; o < 512; o += nw_) {
      const int h = o & 127, lk = o >> 7; const float* pe = P.cmp_pe + (long)lk * 2048; const float* w1 = P.cmp_w1 + (long)lk * 2048 * 128 + h; float s = 0.f;
#pragma unroll 8
      for (int k = lane_; k < 2048; k += 64) s += pe[k] * w1[(long)k * 128];
#pragma unroll
      for (int d = 32; d > 0; d >>= 1) s += shx(s, d);
      if (lane_ == 0) P.c1[o] = s;
    }
  }
}

__device__ void phase_rstd(const float* __restrict__ x, float* __restrict__ rstd, u16* __restrict__ hb, bool scaled) {
  const int lane = TIDX_f() & 63, gw = BIDX_f() * 4 + (TIDX_f() >> 6), nw = gridDim.x * 4;
  for (int row = gw; row < TOK; row += nw) {
    const float4* p = (const float4*)(x + (long)row * 1024);
    float4 v[4]; float s = 0.f;
#pragma unroll
    for (int i = 0; i < 4; ++i) { v[i] = p[lane + 64 * i]; s += v[i].x * v[i].x + v[i].y * v[i].y + v[i].z * v[i].z + v[i].w * v[i].w; }
#pragma unroll
    for (int o = 32; o > 0; o >>= 1) s += shx(s, o);
    float r = rsqrtf(s * (1.f / 1024.f) + 1e-6f);
    if (lane == 0) rstd[row] = r;
    if (hb) {
      const float r_ = r; (void)r_;
      if (!scaled) r = 1.f;
#pragma unroll
      for (int i = 0; i < 4; ++i) { uint2 o; o.x = pack2(v[i].x * r, v[i].y * r); o.y = pack2(v[i].z * r, v[i].w * r); *(uint2*)(hb + (long)row * 1024 + (lane + 64 * i) * 4) = o; }
    }
  }
}
__device__ void phase_final_norm(float* __restrict__ x, const float* __restrict__ g) {
  const int lane = TIDX_f() & 63, gw = BIDX_f() * 4 + (TIDX_f() >> 6), nw = gridDim.x * 4;
  for (int row = gw; row < TOK; row += nw) {
    float4* p = (float4*)(x + (long)row * 1024);
    float4 v[4]; float s = 0.f;
#pragma unroll
    for (int i = 0; i < 4; ++i) { v[i] = p[lane + 64 * i]; s += v[i].x * v[i].x + v[i].y * v[i].y + v[i].z * v[i].z + v[i].w * v[i].w; }
#pragma unroll
    for (int o = 32; o > 0; o >>= 1) s += shx(s, o);
    float r = rsqrtf(s * (1.f / 1024.f) + 1e-6f);
#pragma unroll
    for (int i = 0; i < 4; ++i) { float4 gg = ((const float4*)g)[lane + 64 * i]; float4 o; o.x = v[i].x * r * gg.x; o.y = v[i].y * r * gg.y; o.z = v[i].z * r * gg.z; o.w = v[i].w * r * gg.w; p[lane + 64 * i] = o; }
  }
}

template <bool AF32>
__device__ __forceinline__ uint4 ld_a(const void* __restrict__ Ap, long lda, int k0, int c) {
  if (AF32) return *(const uint4*)((const float*)Ap + (long)(c >> 4) * lda + k0 + (c & 15) * 4);
  return *(const uint4*)((const u16*)Ap + (long)(c >> 3) * lda + k0 + (c & 7) * 8);
}
template <bool AF32>
__device__ __forceinline__ void st_a(u16* sA, int c, uint4 v) {
  if (AF32) { uint2 o; o.x = pack2(__uint_as_float(v.x), __uint_as_float(v.y)); o.y = pack2(__uint_as_float(v.z), __uint_as_float(v.w)); *(uint2*)(sA + (c >> 4) * 72 + (c & 15) * 4) = o; }
  else *(uint4*)(sA + (c >> 3) * 72 + (c & 7) * 8) = v;
}
__device__ __forceinline__ uint4 ld_b(const u16* __restrict__ Bp, long ldb, int k0, int c) { return *(const uint4*)(Bp + (long)(c >> 3) * ldb + k0 + (c & 7) * 8); }
__device__ __forceinline__ void st_b(u16* sB, int c, uint4 v) { *(uint4*)(sB + (c >> 3) * 72 + (c & 7) * 8) = v; }

template <int NT, bool AF32>
__device__ __forceinline__ void gemm_acc(f32x4 (&acc)[4][NT], const void* __restrict__ Ap, long lda, const u16* __restrict__ Bp, long ldb, int K, u16* sA, u16* sB) {
  const int tid = TIDX_f(), lane = tid & 63, wid = tid >> 6, wr = wid >> 1, wc = wid & 1, l16 = lane & 15, q4 = lane >> 4;
  uint4 ra0, ra1, ra2, ra3, ra4, ra5, ra6, ra7, rb0, rb1, rb2, rb3;
  ra4 = ra5 = ra6 = ra7 = rb2 = rb3 = make_uint4(0, 0, 0, 0);
#define GLOAD(k0)                                                                                   \
  {                                                                                                 \
    ra0 = ld_a<AF32>(Ap, lda, (k0), tid); ra1 = ld_a<AF32>(Ap, lda, (k0), tid + 256);               \
    ra2 = ld_a<AF32>(Ap, lda, (k0), tid + 512); ra3 = ld_a<AF32>(Ap, lda, (k0), tid + 768);         \
    if (AF32) { ra4 = ld_a<AF32>(Ap, lda, (k0), tid + 1024); ra5 = ld_a<AF32>(Ap, lda, (k0), tid + 1280); \
                ra6 = ld_a<AF32>(Ap, lda, (k0), tid + 1536); ra7 = ld_a<AF32>(Ap, lda, (k0), tid + 1792); } \
    rb0 = ld_b(Bp, ldb, (k0), tid); rb1 = ld_b(Bp, ldb, (k0), tid + 256);                           \
    if (NT == 4) { rb2 = ld_b(Bp, ldb, (k0), tid + 512); rb3 = ld_b(Bp, ldb, (k0), tid + 768); }   \
  }
  GLOAD(0);
  for (int k0 = 0; k0 < K; k0 += 64) {
    __syncthreads();
    st_a<AF32>(sA, tid, ra0); st_a<AF32>(sA, tid + 256, ra1); st_a<AF32>(sA, tid + 512, ra2); st_a<AF32>(sA, tid + 768, ra3);
    if (AF32) { st_a<AF32>(sA, tid + 1024, ra4); st_a<AF32>(sA, tid + 1280, ra5); st_a<AF32>(sA, tid + 1536, ra6); st_a<AF32>(sA, tid + 1792, ra7); }
    st_b(sB, tid, rb0); st_b(sB, tid + 256, rb1);
    if (NT == 4) { st_b(sB, tid + 512, rb2); st_b(sB, tid + 768, rb3); }
    __syncthreads();
    if (k0 + 64 < K) GLOAD(k0 + 64);
#pragma unroll
    for (int ks = 0; ks < 2; ++ks) {
      bf16x8 af[4], bfr[NT];
#pragma unroll
      for (int m = 0; m < 4; ++m) af[m] = *(const bf16x8*)(sA + (wr * 64 + m * 16 + l16) * 72 + ks * 32 + q4 * 8);
#pragma unroll
      for (int n = 0; n < NT; ++n) bfr[n] = *(const bf16x8*)(sB + (wc * NT * 16 + n * 16 + l16) * 72 + ks * 32 + q4 * 8);
#pragma unroll
      for (int m = 0; m < 4; ++m)
#pragma unroll
        for (int n = 0; n < NT; ++n) acc[m][n] = MFMA(bfr[n], af[m], acc[m][n]);
    }
  }
#undef GLOAD
}

#define FOR_TILES(NTN)                                                                         \
  const int nsup_ = 32 * ((NTN) / 4);                                                          \
  const int xcd_ = BIDX_f() & 7, lid_ = BIDX_f() >> 3, nl_ = gridDim.x >> 3;              \
  for (int st_ = xcd_; st_ < nsup_; st_ += 8)                                                  \
    for (int w_ = lid_; w_ < 64; w_ += nl_)

#define TILE_MN(NTN) const int mt = ((NTN) == 8) ? (st_ * 8 + (w_ & 7)) : ((st_ / ((NTN) / 4)) * 16 + (w_ & 15)), nt = ((NTN) == 8) ? (w_ >> 3) : ((st_ % ((NTN) / 4)) * 4 + (w_ >> 4));

__device__ __forceinline__ void gemm_acc8(f32x4 (&acc)[4][8], const u16* __restrict__ Ap, long lda, const u16* __restrict__ Bp, long ldb, int K, u16* sA, u16* sB) {
  const int tid = TIDX_f(), lane = tid & 63, wid = tid >> 6, wr = wid >> 1, wc = wid & 1, l16 = lane & 15, q4 = lane >> 4;
  uint4 ra0, ra1, rb0, rb1, rb2, rb3;
#define LD32(P_, ld_, k0, c) (*(const uint4*)((P_) + (long)((c) >> 2) * (ld_) + (k0) + ((c) & 3) * 8))
#define ST32(S_, c, v) (*(uint4*)((S_) + ((c) >> 2) * 40 + ((c) & 3) * 8) = (v))
#define GLOAD8(k0)                                                             \
  {                                                                            \
    ra0 = LD32(Ap, lda, (k0), tid); ra1 = LD32(Ap, lda, (k0), tid + 256);      \
    rb0 = LD32(Bp, ldb, (k0), tid); rb1 = LD32(Bp, ldb, (k0), tid + 256);      \
    rb2 = LD32(Bp, ldb, (k0), tid + 512); rb3 = LD32(Bp, ldb, (k0), tid + 768); \
  }
  GLOAD8(0);
  for (int k0 = 0; k0 < K; k0 += 32) {
    __syncthreads();
    ST32(sA, tid, ra0); ST32(sA, tid + 256, ra1);
    ST32(sB, tid, rb0); ST32(sB, tid + 256, rb1); ST32(sB, tid + 512, rb2); ST32(sB, tid + 768, rb3);
    __syncthreads();
    if (k0 + 32 < K) GLOAD8(k0 + 32);
    bf16x8 af[4];
#pragma unroll
    for (int m = 0; m < 4; ++m) af[m] = *(const bf16x8*)(sA + (wr * 64 + m * 16 + l16) * 40 + q4 * 8);
#pragma unroll
    for (int hf = 0; hf < 2; ++hf) {
      bf16x8 bfr[4];
#pragma unroll
      for (int n = 0; n < 4; ++n) bfr[n] = *(const bf16x8*)(sB + (wc * 128 + (hf * 4 + n) * 16 + l16) * 40 + q4 * 8);
#pragma unroll
      for (int m = 0; m < 4; ++m)
#pragma unroll
        for (int n = 0; n < 4; ++n) acc[m][hf * 4 + n] = MFMA(bfr[n], af[m], acc[m][hf * 4 + n]);
    }
  }
#undef GLOAD8
#undef LD32
#undef ST32
}

__device__ void phase_inproj(const Params& P, int layer, const float* xin, char* lds) {
  u16* sA = (u16*)lds; u16* sB = sA + 128 * 40;
  const int lane = TIDX_f() & 63, wid = TIDX_f() >> 6, wr = wid >> 1, wc = wid & 1, l16 = lane & 15, q4 = lane >> 4;
  const u16* W = P.WinT + (long)layer * LD * 1024;
  const int xcd_ = BIDX_f() & 7, lid_ = BIDX_f() >> 3, nl_ = gridDim.x >> 3;
  for (int st_ = xcd_; st_ < 176; st_ += 8)
    for (int w_ = lid_; w_ < 64; w_ += nl_) {
      const int mt = (st_ / 11) * 32 + (w_ & 31), nt = (st_ % 11) * 2 + (w_ >> 5);
      f32x4 acc[4][8];
#pragma unroll
      for (int m = 0; m < 4; ++m)
#pragma unroll
        for (int n = 0; n < 8; ++n) acc[m][n] = zero4();
      gemm_acc8(acc, P.hb + (long)mt * 128 * 1024, 1024, W + (long)nt * 256 * 1024, 1024, 1024, sA, sB);
#pragma unroll
      for (int m = 0; m < 4; ++m) {
        const int row = mt * 128 + wr * 64 + m * 16 + l16;
        const float r = P.rstd[row];
#pragma unroll
        for (int n = 0; n < 8; ++n) {
          const int cb = nt * 256 + wc * 128 + n * 16;
          f32x4 v = acc[m][n] * r;
          const bool trs = (cb >= 896) && (cb < 1024), trw = (cb >= 1152) && (cb < 1280);
          const bool kss = (cb >= 768) && (cb < 896), ksw = (cb >= 1024) && (cb < 1152);
          if ((cb >= C_RS) && (cb < C_RZ)) {
            const int rel = cb - C_RS + q4 * 4, sb = rel & ~63, j = rel & 63;
            uint2 o; o.x = pack2(v[0], v[1]); o.y = pack2(v[2], v[3]);
            *(uint2*)(P.proj + (long)((row & ~15) + (j >> 4) * 4 + ((j >> 2) & 3)) * LD + C_RS + sb + (row & 15) * 4) = o;
          } else if (kss || ksw) {
            const int kbase = kss ? 768 : 1024;
            const int dd = cb - kbase + q4 * 4, g = dd >> 6, d = dd & 63;
            uint2 o; o.x = pack2(v[0], v[1]); o.y = pack2(v[2], v[3]);
            *(uint2*)(P.proj + (long)((row & ~15) + g * 8 + (d >> 3)) * LD + kbase + (row & 15) * 8 + (d & 7)) = o;
          } else if (!(trs || trw)) {
            uint2 o; o.x = pack2(v[0], v[1]); o.y = pack2(v[2], v[3]);
            *(uint2*)(P.proj + (long)row * LD + cb + q4 * 4) = o;
          } else {
            const int dd = cb - (trs ? 896 : 1152) + q4 * 4;
            const int b = row >> 13, s = row & 8191, g = dd >> 6, d = dd & 63;
            const int kk = s & 63;
            u16* dp = (trs ? P.vsT : P.vwT) + ((long)(b * 2 + g) * 128 + (s >> 6)) * 4096
                      + ((((d >> 4) * 2 + (kk >> 5)) * 64 + ((kk >> 3) & 3) * 16 + (d & 15)) * 8) + (kk & 7);
            dp[0] = f2bf(v[0]); dp[8] = f2bf(v[1]); dp[16] = f2bf(v[2]); dp[24] = f2bf(v[3]);
          }
        }
      }
    }
}

__device__ void phase_merge(const Params& P, int layer, const float* xin, char* lds) {
  u16* sA = (u16*)lds; u16* sB = sA + 128 * 72;
  const int lane = TIDX_f() & 63, wid = TIDX_f() >> 6, wr = wid >> 1, wc = wid & 1, l16 = lane & 15, q4 = lane >> 4;
  const u16* Wmg = P.WmgT + (long)layer * 3072 * 1024;
  const u16* Wbr = P.WbrT + (long)layer * 3 * 1024 * 512;
  FOR_TILES(8) {
    TILE_MN(8)
    unsigned zpk[4][4][2];
#pragma unroll
    for (int m = 0; m < 4; ++m)
#pragma unroll
      for (int n = 0; n < 4; ++n) { zpk[m][n][0] = 0u; zpk[m][n][1] = 0u; }
    for (int br = 0; br < 3; ++br) {
      unsigned gpk[4][4][2];
      {
        f32x4 a1[4][4];
#pragma unroll
        for (int m = 0; m < 4; ++m)
#pragma unroll
          for (int n = 0; n < 4; ++n) a1[m][n] = zero4();
        gemm_acc<4, false>(a1, P.hb + (long)mt * 128 * 1024, 1024, Wmg + ((long)br * 1024 + nt * 128) * 1024, 1024, 1024, sA, sB);
#pragma unroll
        for (int m = 0; m < 4; ++m) {
          const float rs = P.rstd[mt * 128 + wr * 64 + m * 16 + l16];
#pragma unroll
          for (int n = 0; n < 4; ++n) {
            gpk[m][n][0] = pack2(sigmoidf_(a1[m][n][0] * rs), sigmoidf_(a1[m][n][1] * rs));
            gpk[m][n][1] = pack2(sigmoidf_(a1[m][n][2] * rs), sigmoidf_(a1[m][n][3] * rs));
            __builtin_amdgcn_sched_barrier(0);
          }
        }
      }
      __builtin_amdgcn_sched_barrier(0);
      {
        f32x4 a2[4][4];
#pragma unroll
        for (int m = 0; m < 4; ++m)
#pragma unroll
          for (int n = 0; n < 4; ++n) a2[m][n] = zero4();
        const int ycol = (br == 0) ? C_NZ : (br == 1 ? C_SZ : C_RZ);
        gemm_acc<4, false>(a2, P.proj + (long)mt * 128 * LD + ycol, LD, Wbr + ((long)br * 1024 + nt * 128) * 512, 512, 512, sA, sB);
#pragma unroll
        for (int m = 0; m < 4; ++m)
#pragma unroll
          for (int n = 0; n < 4; ++n) {
            const float z0 = __uint_as_float(zpk[m][n][0] << 16) + __uint_as_float(gpk[m][n][0] << 16) * a2[m][n][0];
            const float z1 = __uint_as_float(zpk[m][n][0] & 0xffff0000u) + __uint_as_float(gpk[m][n][0] & 0xffff0000u) * a2[m][n][1];
            const float z2 = __uint_as_float(zpk[m][n][1] << 16) + __uint_as_float(gpk[m][n][1] << 16) * a2[m][n][2];
            const float z3 = __uint_as_float(zpk[m][n][1] & 0xffff0000u) + __uint_as_float(gpk[m][n][1] & 0xffff0000u) * a2[m][n][3];
            zpk[m][n][0] = pack2(z0, z1); zpk[m][n][1] = pack2(z2, z3);
            __builtin_amdgcn_sched_barrier(0);
          }
      }
      __builtin_amdgcn_sched_barrier(0);
    }
#pragma unroll
    for (int m = 0; m < 4; ++m) {
      const int row = mt * 128 + wr * 64 + m * 16 + l16;
#pragma unroll
      for (int n = 0; n < 4; ++n) {
        const int col = nt * 128 + wc * 64 + n * 16 + q4 * 4;
        uint2 o; o.x = zpk[m][n][0]; o.y = zpk[m][n][1];
        *(uint2*)(P.proj + (long)row * LD + C_MS + col) = o;
      }
    }
  }
}

__device__ void phase_wo(const Params& P, int layer, const float* xin, float* xout, char* lds) {
  u16* sA = (u16*)lds; u16* sB = sA + 128 * 72;
  const int lane = TIDX_f() & 63, wid = TIDX_f() >> 6, wr = wid >> 1, wc = wid & 1, l16 = lane & 15, q4 = lane >> 4;
  const u16* W = P.WoT + (long)layer * 1024 * 1024;
  FOR_TILES(8) {
    TILE_MN(8)
    f32x4 acc[4][4];
#pragma unroll
    for (int m = 0; m < 4; ++m)
#pragma unroll
      for (int n = 0; n < 4; ++n) acc[m][n] = zero4();
    gemm_acc<4, false>(acc, P.proj + (long)mt * 128 * LD + C_MS, LD, W + (long)nt * 128 * 1024, 1024, 1024, sA, sB);
#pragma unroll
    for (int m = 0; m < 4; ++m) {
      const int row = mt * 128 + wr * 64 + m * 16 + l16;
      float ss = 0.f;
#pragma unroll
      for (int n = 0; n < 4; ++n) {
        const int col = nt * 128 + wc * 64 + n * 16 + q4 * 4;
        float4 xi = *(const float4*)(xin + (long)row * 1024 + col);
        float4 o; o.x = xi.x + acc[m][n][0]; o.y = xi.y + acc[m][n][1]; o.z = xi.z + acc[m][n][2]; o.w = xi.w + acc[m][n][3];
        *(float4*)(xout + (long)row * 1024 + col) = o;
        uint2 hb2; hb2.x = pack2(o.x, o.y); hb2.y = pack2(o.z, o.w);
        *(uint2*)(P.hb + (long)row * 1024 + col) = hb2;
        ss += o.x * o.x + o.y * o.y + o.z * o.z + o.w * o.w;
      }
      ss += shx(ss, 16); ss += shx(ss, 32);
      if (q4 == 0) atomicAdd(P.rstd2 + row, ss);
    }
  }
}

__device__ void phase_ple(const Params& P, int layer, float* xio, char* lds) {
  u16* sA = (u16*)lds; u16* sB = sA + 128 * 72;
  const int lane = TIDX_f() & 63, wid = TIDX_f() >> 6, wr = wid >> 1, wc = wid & 1, l16 = lane & 15, q4 = lane >> 4;
  const u16* Wg = P.WgT + (long)layer * 1024 * 1024;
  const u16* Wp = P.WpT + (long)layer * 1024 * 256;
  const float* pl = P.p + (long)layer * TOK * 256;
  FOR_TILES(8) {
    TILE_MN(8)
    unsigned ppk[4][4][2];
    {
      f32x4 a2[4][4];
#pragma unroll
      for (int m = 0; m < 4; ++m)
#pragma unroll
        for (int n = 0; n < 4; ++n) a2[m][n] = zero4();
      gemm_acc<4, true>(a2, pl + (long)mt * 128 * 256, 256, Wp + (long)nt * 128 * 256, 256, 256, sA, sB);
#pragma unroll
      for (int m = 0; m < 4; ++m)
#pragma unroll
        for (int n = 0; n < 4; ++n) { ppk[m][n][0] = pack2(a2[m][n][0], a2[m][n][1]); ppk[m][n][1] = pack2(a2[m][n][2], a2[m][n][3]); }
    }
    __builtin_amdgcn_sched_barrier(0);
    f32x4 a1[4][4];
#pragma unroll
    for (int m = 0; m < 4; ++m)
#pragma unroll
      for (int n = 0; n < 4; ++n) a1[m][n] = zero4();
    gemm_acc<4, false>(a1, P.hb + (long)mt * 128 * 1024, 1024, Wg + (long)nt * 128 * 1024, 1024, 1024, sA, sB);
#pragma unroll
    for (int m = 0; m < 4; ++m) {
      const int row = mt * 128 + wr * 64 + m * 16 + l16;
      const float rs2 = rsqrtf(P.rstd2[row] * (1.f / 1024.f) + 1e-6f);
#pragma unroll
      for (int n = 0; n < 4; ++n) {
        const int col = nt * 128 + wc * 64 + n * 16 + q4 * 4;
        float4 xi = *(const float4*)(xio + (long)row * 1024 + col);
        float4 o;
        o.x = xi.x + sigmoidf_(a1[m][n][0] * rs2) * __uint_as_float(ppk[m][n][0] << 16);
        o.y = xi.y + sigmoidf_(a1[m][n][1] * rs2) * __uint_as_float(ppk[m][n][0] & 0xffff0000u);
        o.z = xi.z + sigmoidf_(a1[m][n][2] * rs2) * __uint_as_float(ppk[m][n][1] << 16);
        o.w = xi.w + sigmoidf_(a1[m][n][3] * rs2) * __uint_as_float(ppk[m][n][1] & 0xffff0000u);
        *(float4*)(xio + (long)row * 1024 + col) = o;
      }
    }
  }
}

__device__ void compress_item(const Params& P, int layer, int item) {
  const int lane = TIDX_f() & 63, l16 = lane & 15, q4 = lane >> 4;
  const int ntile = item & 31, kv = (item >> 5) & 1, g = (item >> 6) & 1, b = item >> 7;
  int n = ntile * 16 + l16; const int nl = n > 510 ? 510 : n;
  const u16* W1 = P.W1T + (long)(layer * 2 + kv) * 128 * 2048;
  const u16* W2 = P.W2T + (long)(layer * 2 + kv) * 64 * 128;
  const u16* src = P.proj + ((long)b * SEQ + 16 * nl) * LD + (kv ? C_VC : C_KC) + g * 64 + q4 * 8;
  f32x4 acc[8];
#pragma unroll
  for (int i = 0; i < 8; ++i) acc[i] = zero4();
#pragma unroll 2
  for (int kstep = 0; kstep < 64; ++kstep) {
    const int l = kstep >> 1, dofs = (kstep & 1) * 32;
    bf16x8 bf = *(const bf16x8*)(src + (long)l * LD + dofs);
#pragma unroll
    for (int mt = 0; mt < 8; ++mt) {
      bf16x8 af = *(const bf16x8*)(W1 + (long)(mt * 16 + l16) * 2048 + kstep * 32 + q4 * 8);
      acc[mt] = MFMA(af, bf, acc[mt]);
    }
  }
  const float* c1 = P.c1 + (layer * 2 + kv) * 128;
  bf16x8 hf[4];
#pragma unroll
  for (int ks = 0; ks < 4; ++ks) {
    float hv[8];
#pragma unroll
    for (int jj = 0; jj < 8; ++jj) { int mt = 2 * ks + (jj >> 2), reg = jj & 3; float v = acc[mt][reg] + c1[16 * mt + 4 * q4 + reg]; hv[jj] = siluf_(v); }
    hf[ks] = pack8(hv[0], hv[1], hv[2], hv[3], hv[4], hv[5], hv[6], hv[7]);
  }
  f32x4 o[4];
#pragma unroll
  for (int m2 = 0; m2 < 4; ++m2) {
    o[m2] = zero4();
#pragma unroll
    for (int ks = 0; ks < 4; ++ks) {
      const u16* wp = W2 + (long)(m2 * 16 + l16) * 128 + 32 * ks + 4 * q4;
      bf16x8 af = cat44(*(const bf16x4*)wp, *(const bf16x4*)(wp + 16));
      o[m2] = MFMA(af, hf[ks], o[m2]);
    }
  }
  const int bg = b * 2 + g;
  const bool valid = n <= 510;
#pragma unroll
  for (int m2 = 0; m2 < 4; ++m2) {
    const int d = 16 * m2 + 4 * q4;
    f32x4 v = o[m2]; if (!valid) v = zero4();
    const int nk = n & 63;
    if (kv == 0) {
      uint2 w; w.x = pack2(v[0], v[1]); w.y = pack2(v[2], v[3]);
      *(uint2*)(P.kc + ((long)bg * 8 + (n >> 6)) * 4096 + ((((nk >> 4) * 2 + (d >> 5)) * 64 + ((d >> 3) & 3) * 16 + (nk & 15)) * 8) + (d & 7)) = w;
    } else {
      u16* dp = P.vcT + ((long)bg * 8 + (n >> 6)) * 4096 + ((((d >> 4) * 2 + (nk >> 5)) * 64 + ((nk >> 3) & 3) * 16 + (d & 15)) * 8) + (nk & 7);
      dp[0] = f2bf(v[0]); dp[8] = f2bf(v[1]); dp[16] = f2bf(v[2]); dp[24] = f2bf(v[3]);
    }
  }
}

__device__ void sgprep_item(const Params& P, int layer, int item, char* lds) {
  u16* tile = (u16*)lds;
  const int tid = TIDX_f(), lane = tid & 63, w = tid >> 6;
  const int b = item >> 8, s0 = (item & 255) * 32;
  const float* lg = P.sg_ln_g + layer * 512 + lane * 8; const float* lb = P.sg_ln_b + layer * 512 + lane * 8;
  __syncthreads();
#pragma unroll
  for (int tk = 0; tk < 8; ++tk) {
    const long tok = (long)b * SEQ + s0 + w * 8 + tk;
    bf16x8 raw = *(const bf16x8*)(P.proj + tok * LD + C_SV + lane * 8);
    float v[8]; float s = 0.f;
#pragma unroll
    for (int k = 0; k < 8; ++k) { v[k] = bf2f((u16)raw[k]); s += v[k]; }
#pragma unroll
    for (int o = 32; o > 0; o >>= 1) s += shx(s, o);
    const float mean = s * (1.f / 512.f); float q = 0.f;
#pragma unroll
    for (int k = 0; k < 8; ++k) { v[k] -= mean; q += v[k] * v[k]; }
#pragma unroll
    for (int o = 32; o > 0; o >>= 1) q += shx(q, o);
    const float r = rsqrtf(q * (1.f / 512.f) + 1e-5f);
#pragma unroll
    for (int k = 0; k < 8; ++k) tile[(lane * 8 + k) * 40 + w * 8 + tk] = f2bf(v[k] * r * lg[k] + lb[k]);
  }
  __syncthreads();
#pragma unroll
  for (int i = 0; i < 8; ++i) { int idx = tid + 256 * i, ch = idx >> 2, seg = idx & 3; const int si = (s0 & 127) + seg * 8;
    *(uint4*)(P.vnT + (((((long)b * 64 + (s0 >> 7)) * 8 + (ch >> 6)) * 4 + ((ch >> 4) & 3)) * 4 + (si >> 5)) * 512 + (((si >> 3) & 3) * 16 + (ch & 15)) * 8) = *(const uint4*)(tile + ch * 40 + seg * 8); }
}

__device__ void sg_item(const Params& P, int layer, int si) {
  const int lane = TIDX_f() & 63, l16 = lane & 15, q4 = lane >> 4;
  const int w = si & 3, g = (si >> 2) & 7, c = (si >> 5) & 63, b = si >> 11;
  const u16* W = P.sgW + ((long)(layer * 8 + g) * 8) * 4 * 512;
  const u16* V = P.vnT + ((((long)b * 64 + c) * 8 + g) * 16) * 512;
  f32x4 acc[2][4];
#pragma unroll
  for (int i = 0; i < 2; ++i)
#pragma unroll
    for (int d = 0; d < 4; ++d) acc[i][d] = zero4();
  for (int ks = 0; ks < 4; ++ks) {
    if (32 * ks > (2 * w + 1) * 16 + 15) break;
    bf16x8 vf[4];
#pragma unroll
    for (int d = 0; d < 4; ++d) vf[d] = *(const bf16x8*)(V + ((d * 4 + ks) * 64 + lane) * 8);
#pragma unroll
    for (int ti = 0; ti < 2; ++ti) {
      bf16x8 wf = *(const bf16x8*)(W + (((2 * w + ti) * 4 + ks) * 64 + lane) * 8);
#pragma unroll
      for (int d = 0; d < 4; ++d) acc[ti][d] = MFMA(vf[d], wf, acc[ti][d]);
    }
  }
#pragma unroll
  for (int ti = 0; ti < 2; ++ti) {
    const int t = (2 * w + ti) * 16 + l16;
    const long tok = (long)b * SEQ + c * 128 + t;
    const float bias = P.sg_b[(layer * 8 + g) * 128 + t];
#pragma unroll
    for (int d = 0; d < 4; ++d) {
      const int ch = g * 64 + d * 16 + q4 * 4;
      bf16x4 u4 = *(const bf16x4*)(P.proj + tok * LD + C_SU + ch);
      bf16x4 z4 = *(const bf16x4*)(P.proj + tok * LD + C_SZ + ch);
      float o[4];
#pragma unroll
      for (int r = 0; r < 4; ++r) o[r] = bf2f((u16)u4[r]) * (acc[ti][d][r] + bias) * siluf_(bf2f((u16)z4[r]));
      uint2 ov; ov.x = pack2(o[0], o[1]); ov.y = pack2(o[2], o[3]);
      *(uint2*)(P.proj + tok * LD + C_SZ + ch) = ov;
    }
  }
}

struct AttnSt { f32x4 o[4]; float m[4], l[4]; };

__device__ __forceinline__ void load_k(bf16x8 (&kf)[4][2], const u16* __restrict__ Kp, long kstride, int l16, int q4) {
#pragma unroll
  for (int nt = 0; nt < 4; ++nt)
#pragma unroll
    for (int ks = 0; ks < 2; ++ks) kf[nt][ks] = *(const bf16x8*)(Kp + (long)(nt * 16 + ks * 4 + q4) * kstride + l16 * 8);
}
__device__ __forceinline__ void attn_block(AttnSt& st, const bf16x8 (&qf)[2], const bf16x8 (&kf)[4][2], const u16* __restrict__ VTp, long vstride,
                                           const bool (&valid)[4], u16* pbuf, int l16, int q4) {
  bf16x8 vf[4][2];
#pragma unroll
  for (int dt = 0; dt < 4; ++dt)
#pragma unroll
    for (int ks = 0; ks < 2; ++ks) vf[dt][ks] = *(const bf16x8*)(VTp + ((dt * 2 + ks) * 64 + q4 * 16 + l16) * 8);
  f32x4 s[4];
#pragma unroll
  for (int nt = 0; nt < 4; ++nt) { s[nt] = MFMA(qf[0], kf[nt][0], zero4()); s[nt] = MFMA(qf[1], kf[nt][1], s[nt]); }
#pragma unroll
  for (int nt = 0; nt < 4; ++nt) { const float bsc = valid[nt] ? 0.f : -1e30f; const f32x4 bv = {bsc, bsc, bsc, bsc}; s[nt] = s[nt] * 0.18033688f + bv; }
  f32x4 mv = {st.m[0], st.m[1], st.m[2], st.m[3]};
  const f32x4 mxl = __builtin_elementwise_max(__builtin_elementwise_max(s[0], s[1]), __builtin_elementwise_max(s[2], s[3]));
  const f32x4 dm = mxl - mv;
  const bool need = (dm[0] > 8.f) || (dm[1] > 8.f) || (dm[2] > 8.f) || (dm[3] > 8.f);
  if (__builtin_amdgcn_ballot_w64(need) != 0ull) {
#pragma unroll
    for (int r = 0; r < 4; ++r) {
      const float mx = red16_max(mxl[r]);
      const float mnew = fmaxf(st.m[r], mx);
      const float alpha = __builtin_amdgcn_exp2f(st.m[r] - mnew);
      st.l[r] *= alpha; st.m[r] = mnew; mv[r] = mnew;
#pragma unroll
      for (int dt = 0; dt < 4; ++dt) st.o[dt][r] *= alpha;
    }
  }
  f32x4 rsv = zero4();
#pragma unroll
  for (int nt = 0; nt < 4; ++nt) {
    const f32x4 d = s[nt] - mv;
    f32x4 p;
#pragma unroll
    for (int r = 0; r < 4; ++r) p[r] = __builtin_amdgcn_exp2f(d[r]);
    s[nt] = p; rsv += p;
  }
#pragma unroll
  for (int r = 0; r < 4; ++r) st.l[r] += rsv[r];
#pragma unroll
  for (int nt = 0; nt < 4; ++nt)
#pragma unroll
    for (int r = 0; r < 4; ++r) pbuf[(q4 * 4 + r) * 72 + nt * 16 + l16] = f2bf(s[nt][r]);
  wave_sync();
  bf16x8 pf[2];
  pf[0] = *(const bf16x8*)(pbuf + l16 * 72 + q4 * 8);
  pf[1] = *(const bf16x8*)(pbuf + l16 * 72 + 32 + q4 * 8);
  wave_sync();
#pragma unroll
  for (int dt = 0; dt < 4; ++dt) { st.o[dt] = MFMA(pf[0], vf[dt][0], st.o[dt]); st.o[dt] = MFMA(pf[1], vf[dt][1], st.o[dt]); }
}

__device__ void nsa_item(const Params& P, int wi, char* wlds) {
  float* pl = (float*)wlds;
  u16* pbuf = (u16*)(wlds + 8192);
  unsigned* flags = (unsigned*)(wlds + 8192 + 2304);
  const int lane = TIDX_f() & 63, l16 = lane & 15, q4 = lane >> 4;
  const int bg = wi >> 11, b = bg >> 1, g = bg & 1;
  const int t0 = (2047 - (wi & 2047)) * 4;
  u16* proj = P.proj;
  const long tokb = (long)b * SEQ;
  const int tme = t0 + q4;
  bf16x8 qf[2];
  { const u16* qp = proj + (tokb + t0 + (l16 >> 2)) * LD + C_Q + g * 256 + (l16 & 3) * 64 + q4 * 8; qf[0] = *(const bf16x8*)qp; qf[1] = *(const bf16x8*)(qp + 32); }
  float gate[4][3];
  { const u16* gp = proj + (tokb + tme) * LD + C_NG + g * 12;
#pragma unroll
    for (int r = 0; r < 4; ++r)
#pragma unroll
      for (int x = 0; x < 3; ++x) gate[r][x] = sigmoidf_(bf2f(gp[r * 3 + x])); }
  f32x4 y[4];
#pragma unroll
  for (int d = 0; d < 4; ++d) y[d] = zero4();
#pragma unroll
  for (int i = 0; i < 8; ++i) *(float4*)(pl + lane * 32 + i * 4) = make_float4(0.f, 0.f, 0.f, 0.f);
  wave_sync();
  {
    const u16* Kc = P.kc + (long)bg * 512 * 64;
    const u16* VcT = P.vcT + (long)bg * 8 * 4096;
    const int nmax_me = (tme - 31) >> 4;
    const int nmax_hi = (t0 + 3 - 31) >> 4;
    const int nblk = nmax_hi >= 0 ? (nmax_hi >> 6) + 1 : 0;
    float m[4], l[4];
#pragma unroll
    for (int r = 0; r < 4; ++r) { m[r] = -1e30f; l[r] = 0.f; }
    for (int blk = 0; blk < nblk; ++blk) {
      f32x4 s[4]; bool valid[4];
#pragma unroll
      for (int nt = 0; nt < 4; ++nt) {
        const u16* kp = Kc + (long)blk * 4096 + ((nt * 2) * 64 + q4 * 16 + l16) * 8;
        s[nt] = MFMA(qf[0], *(const bf16x8*)kp, zero4()); s[nt] = MFMA(qf[1], *(const bf16x8*)(kp + 512), s[nt]);
        valid[nt] = (blk * 64 + nt * 16 + l16) <= nmax_me;
      }
#pragma unroll
      for (int r = 0; r < 4; ++r) {
        float mx = -1e30f;
#pragma unroll
        for (int nt = 0; nt < 4; ++nt) { float sv = valid[nt] ? s[nt][r] * 0.18033688f : -1e30f; s[nt][r] = sv; mx = fmaxf(mx, sv); }
        mx = red16_max(mx);
        const float mnew = fmaxf(m[r], mx);
        float rs = 0.f;
#pragma unroll
        for (int nt = 0; nt < 4; ++nt) rs += valid[nt] ? __builtin_amdgcn_exp2f(s[nt][r] - mnew) : 0.f;
        l[r] = l[r] * __builtin_amdgcn_exp2f(m[r] - mnew) + rs; m[r] = mnew;
      }
    }
    float il[4];
#pragma unroll
    for (int r = 0; r < 4; ++r) { const float lt = red16_sum(l[r]); il[r] = lt > 0.f ? 1.f / lt : 0.f; }
    f32x4 oc[4];
#pragma unroll
    for (int d = 0; d < 4; ++d) oc[d] = zero4();
    for (int blk = 0; blk < nblk; ++blk) {
      f32x4 s[4];
#pragma unroll
      for (int nt = 0; nt < 4; ++nt) {
        const u16* kp = Kc + (long)blk * 4096 + ((nt * 2) * 64 + q4 * 16 + l16) * 8;
        s[nt] = MFMA(qf[0], *(const bf16x8*)kp, zero4()); s[nt] = MFMA(qf[1], *(const bf16x8*)(kp + 512), s[nt]);
        const bool valid = (blk * 64 + nt * 16 + l16) <= nmax_me;
        float ps = 0.f;
#pragma unroll
        for (int r = 0; r < 4; ++r) { float p = valid ? __builtin_amdgcn_exp2f(s[nt][r] * 0.18033688f - m[r]) * il[r] : 0.f; s[nt][r] = p; ps += p; }
        pl[q4 * 512 + blk * 64 + nt * 16 + l16] = ps;
#pragma unroll
        for (int r = 0; r < 4; ++r) pbuf[(q4 * 4 + r) * 72 + nt * 16 + l16] = f2bf(s[nt][r]);
      }
      wave_sync();
      bf16x8 pf0 = *(const bf16x8*)(pbuf + l16 * 72 + q4 * 8);
      bf16x8 pf1 = *(const bf16x8*)(pbuf + l16 * 72 + 32 + q4 * 8);
      wave_sync();
#pragma unroll
      for (int dt = 0; dt < 4; ++dt) {
        const u16* vp = VcT + (long)blk * 4096 + ((dt * 2) * 64 + q4 * 16 + l16) * 8;
        oc[dt] = MFMA(pf0, *(const bf16x8*)vp, oc[dt]); oc[dt] = MFMA(pf1, *(const bf16x8*)(vp + 512), oc[dt]);
      }
    }
#pragma unroll
    for (int dt = 0; dt < 4; ++dt)
#pragma unroll
      for (int r = 0; r < 4; ++r) y[dt][r] += gate[r][0] * oc[dt][r];
  }
  wave_sync();
  const int tblk = t0 >> 6;
  {
    unsigned key[8]; unsigned selm = 0;
    const int need = 16 - (tblk == 0 ? 1 : (tblk == 1 ? 2 : 3));
#pragma unroll
    for (int k = 0; k < 8; ++k) {
      const int j = l16 * 8 + k;
      float imp = 0.f;
#pragma unroll
      for (int i = -1; i <= 3; ++i) { int ii = 4 * j + i; if (ii >= 0 && ii <= 510) imp += pl[q4 * 512 + ii]; }
      const bool forced = (j == 0) || (j == tblk) || (j == tblk - 1);
      const bool cand = (j <= tblk) && !forced;
      key[k] = cand ? ((__float_as_uint(imp) & ~127u) | (unsigned)(127 - j)) : 0u;
      if (forced && j <= tblk) selm |= 1u << k;
    }
    for (int it = 0; it < 13; ++it) {
      unsigned mx = 0;
#pragma unroll
      for (int k = 0; k < 8; ++k) mx = key[k] > mx ? key[k] : mx;
      mx = max(mx, (unsigned)shx((int)mx, 1)); mx = max(mx, (unsigned)shx((int)mx, 2));
      mx = max(mx, (unsigned)shx((int)mx, 4)); mx = max(mx, (unsigned)shx((int)mx, 8));
      const bool act = (it < need) && (mx != 0u);
#pragma unroll
      for (int k = 0; k < 8; ++k) if (act && key[k] == mx) { selm |= 1u << k; key[k] = 0u; }
    }
#pragma unroll
    for (int k = 0; k < 8; ++k) {
      const unsigned long long bal = __ballot((selm >> k) & 1u);
      if (q4 == 0) {
        unsigned wd = (unsigned)((bal >> l16) & 1ull) | ((unsigned)((bal >> (16 + l16)) & 1ull) << 1) | ((unsigned)((bal >> (32 + l16)) & 1ull) << 2) | ((unsigned)((bal >> (48 + l16)) & 1ull) << 3);
        flags[l16 * 8 + k] = wd;
      }
    }
  }
  wave_sync();
  {
    AttnSt st;
#pragma unroll
    for (int d = 0; d < 4; ++d) st.o[d] = zero4();
#pragma unroll
    for (int r = 0; r < 4; ++r) { st.m[r] = -1e4f; st.l[r] = 0.f; }
    const u16* Kb = proj + (tokb + g * 8) * LD + C_KS;
    const u16* Vb = P.vsT + (long)bg * 128 * 4096;
    int j = 0;
    while (j <= tblk && __builtin_amdgcn_readfirstlane(flags[j]) == 0u) ++j;
    bf16x8 kA[4][2], kB[4][2];
    if (j <= tblk) load_k(kA, Kb + (long)j * 64 * LD, LD, l16, q4);
#define SEL_STEP(KC, KN)                                                                                   \
    {                                                                                                      \
      int jn = j + 1;                                                                                      \
      while (jn <= tblk && __builtin_amdgcn_readfirstlane(flags[jn]) == 0u) ++jn;                          \
      if (jn <= tblk) load_k(KN, Kb + (long)jn * 64 * LD, LD, l16, q4);                                    \
      const unsigned f = __builtin_amdgcn_readfirstlane(flags[j]);                                         \
      const bool sel = (f >> q4) & 1u;                                                                     \
      bool valid[4];                                                                                       \
      _Pragma("unroll") for (int nt = 0; nt < 4; ++nt) valid[nt] = sel && (j * 64 + nt * 16 + l16 <= tme); \
      attn_block(st, qf, KC, Vb + (long)j * 4096, 64, valid, pbuf, l16, q4);                               \
      j = jn;                                                                                              \
    }
    while (j <= tblk) {
      SEL_STEP(kA, kB)
      if (j > tblk) break;
      SEL_STEP(kB, kA)
    }
#undef SEL_STEP
#pragma unroll
    for (int r = 0; r < 4; ++r) { const float lt = red16_sum(st.l[r]); const float sc = lt > 0.f ? gate[r][1] / lt : 0.f;
#pragma unroll
      for (int dt = 0; dt < 4; ++dt) y[dt][r] += sc * st.o[dt][r]; }
  }
  {
    AttnSt st;
#pragma unroll
    for (int d = 0; d < 4; ++d) st.o[d] = zero4();
#pragma unroll
    for (int r = 0; r < 4; ++r) { st.m[r] = -1e4f; st.l[r] = 0.f; }
    const u16* Kb = proj + (tokb + g * 8) * LD + C_KW;
    const u16* Vb = P.vwT + (long)bg * 128 * 4096;
    int j0 = (t0 - 511) >> 6; if (j0 < 0) j0 = 0;
    bf16x8 kA[4][2], kB[4][2];
    load_k(kA, Kb + (long)j0 * 64 * LD, LD, l16, q4);
#define WIN_STEP(KC, KN)                                                                                   \
    {                                                                                                      \
      if (j + 1 <= tblk) load_k(KN, Kb + (long)(j + 1) * 64 * LD, LD, l16, q4);                            \
      bool valid[4];                                                                                       \
      _Pragma("unroll") for (int nt = 0; nt < 4; ++nt) { const int pos = j * 64 + nt * 16 + l16; valid[nt] = (pos <= tme) && (pos > tme - 512); } \
      attn_block(st, qf, KC, Vb + (long)j * 4096, 64, valid, pbuf, l16, q4);                               \
      ++j;                                                                                                 \
    }
    int j = j0;
    while (j <= tblk) {
      WIN_STEP(kA, kB)
      if (j > tblk) break;
      WIN_STEP(kB, kA)
    }
#undef WIN_STEP
#pragma unroll
    for (int r = 0; r < 4; ++r) { const float lt = red16_sum(st.l[r]); const float sc = lt > 0.f ? gate[r][2] / lt : 0.f;
#pragma unroll
      for (int dt = 0; dt < 4; ++dt) y[dt][r] += sc * st.o[dt][r]; }
  }
  {
    u16* op = proj + (tokb + tme) * LD + C_NZ + g * 256 + l16;
#pragma unroll
    for (int r = 0; r < 4; ++r)
#pragma unroll
      for (int dt = 0; dt < 4; ++dt) { u16* e = op + r * 64 + dt * 16; const float z = bf2f(*e); *e = f2bf(y[dt][r] * siluf_(z)); }
  }
  wave_sync();
}

#define SL_RH 0
#define SL_AH 2048
#define SL_WV 4096
#define SL_UV 6144
#define SL_BK 8192
#define SL_VT 12288
#define SL_GC 14336
#define SL_BON 14592
#define SL_M1 14656
#define SL_M2 15168
#define SL_SIZE 16384

__device__ __forceinline__ void ld4s(bf16x4 a, bf16x4 p, const float* mu, float (&o)[4]) {
  float4 m = *(const float4*)mu;
  float x0 = bf2f((u16)a[0]), x1 = bf2f((u16)a[1]), x2 = bf2f((u16)a[2]), x3 = bf2f((u16)a[3]);
  o[0] = x0 + (bf2f((u16)p[0]) - x0) * m.x; o[1] = x1 + (bf2f((u16)p[1]) - x1) * m.y;
  o[2] = x2 + (bf2f((u16)p[2]) - x2) * m.z; o[3] = x3 + (bf2f((u16)p[3]) - x3) * m.w;
}

template <int PASS>
__device__ void rwkv_precompute(const Params& P, int layer, int b, int h, int c, char* sl) {
  const int lane = TIDX_f() & 63, l16 = lane & 15, q4 = lane >> 4;
  u16* RH = (u16*)(sl + SL_RH); u16* AH = (u16*)(sl + SL_AH); u16* WV = (u16*)(sl + SL_WV); u16* UV = (u16*)(sl + SL_UV);
  u16* BK = (u16*)(sl + SL_BK); u16* VT = (u16*)(sl + SL_VT); float* GC = (float*)(sl + SL_GC); float* BON = (float*)(sl + SL_BON);
  u16* M1 = (u16*)(sl + SL_M1); u16* M2 = (u16*)(sl + SL_M2);
  u16* WT1 = RH; u16* WT2 = AH; u16* WT3 = RH; float* AT = (float*)(sl + SL_WV); u16* MBM = UV;
  const long tok = (long)b * SEQ + c * 16 + l16;
  const u16* rowp = P.proj + tok * LD + C_RS;
  const u16* prevp = rowp - LD;
  const u16* tilep = P.proj + ((long)b * SEQ + c * 16) * LD + C_RS;
  const bool hasprev = !(c == 0 && l16 == 0);
  const float* mu = P.rk_mu + layer * 1664;
  const int hj = h * 64;
  bf16x4 rc[5][4], rp[5][4];
  const int poff = (l16 > 0) ? (l16 - 1) * 4 : (60 - 16 * LD);
#pragma unroll
  for (int q = 0; q < 5; ++q) {
    const int cb = (q < 3) ? (q * 512 + hj) : (1536 + (q - 3) * 64);
#pragma unroll
    for (int mt = 0; mt < 4; ++mt) {
      const u16* tp = tilep + (long)(mt * 4 + q4) * LD + cb;
      rc[q][mt] = *(const bf16x4*)(tp + l16 * 4);
      bf16x4 z = {0, 0, 0, 0};
      rp[q][mt] = hasprev ? *(const bf16x4*)(tp + poff) : z;
    }
  }
  f32x4 wacc[4], aacc[4];
  {
    float tw[16], al[16];
#pragma unroll
    for (int mt = 0; mt < 4; ++mt) {
      float t4[4];
      ld4s(rc[3][mt], rp[3][mt], mu + 1536 + 16 * mt + 4 * q4, t4);
#pragma unroll
      for (int r = 0; r < 4; ++r) tw[mt * 4 + r] = 1.f - 2.f * __builtin_amdgcn_rcpf(1.f + __expf(2.f * t4[r]));
      ld4s(rc[4][mt], rp[4][mt], mu + 1600 + 16 * mt + 4 * q4, t4);
#pragma unroll
      for (int r = 0; r < 4; ++r) al[mt * 4 + r] = t4[r];
    }
    bf16x8 twf[2], alf[2];
#pragma unroll
    for (int ks = 0; ks < 2; ++ks) {
      twf[ks] = pack8(tw[ks * 8], tw[ks * 8 + 1], tw[ks * 8 + 2], tw[ks * 8 + 3], tw[ks * 8 + 4], tw[ks * 8 + 5], tw[ks * 8 + 6], tw[ks * 8 + 7]);
      alf[ks] = pack8(al[ks * 8], al[ks * 8 + 1], al[ks * 8 + 2], al[ks * 8 + 3], al[ks * 8 + 4], al[ks * 8 + 5], al[ks * 8 + 6], al[ks * 8 + 7]);
    }
    const u16* w2 = P.w2T + ((long)(layer * 8 + h) * 8) * 512;
    const u16* a2 = P.a2T + ((long)(layer * 8 + h) * 8) * 512;
#pragma unroll
    for (int mt = 0; mt < 4; ++mt) {
      wacc[mt] = zero4(); aacc[mt] = zero4();
#pragma unroll
      for (int ks = 0; ks < 2; ++ks) {
        wacc[mt] = MFMA(*(const bf16x8*)(w2 + ((mt * 2 + ks) * 64 + lane) * 8), twf[ks], wacc[mt]);
        aacc[mt] = MFMA(*(const bf16x8*)(a2 + ((mt * 2 + ks) * 64 + lane) * 8), alf[ks], aacc[mt]);
      }
    }
  }
  __builtin_amdgcn_sched_barrier(0);
  bf16x8 Atf[2], Btf[2], Ktf[2], Rtf[2];
  Rtf[0] = zero8(); Rtf[1] = zero8();
  {
    float logd[16], alr[16], lgl[16], kk[16], km[16];
#pragma unroll
    for (int mt = 0; mt < 4; ++mt) {
      const int jo = 16 * mt + 4 * q4;
      const float4 w0 = *(const float4*)(P.rk_w0 + layer * 512 + hj + jo);
      const float4 a0 = *(const float4*)(P.rk_a0 + layer * 512 + hj + jo);
      const float w0a[4] = {w0.x, w0.y, w0.z, w0.w}, a0a[4] = {a0.x, a0.y, a0.z, a0.w};
#pragma unroll
      for (int r = 0; r < 4; ++r) {
        const int e = mt * 4 + r;
        logd[e] = -0.60653066f * sigmoidf_(w0a[r] + wacc[mt][r]);
        alr[e] = sigmoidf_(a0a[r] + aacc[mt][r]);
      }
    }
  __builtin_amdgcn_sched_barrier(0);
#pragma unroll
    for (int e = 0; e < 16; ++e) {
      float x = logd[e];
      x += __int_as_float(__builtin_amdgcn_update_dpp(0, __float_as_int(x), 0x111, 0xF, 0xF, true));
      x += __int_as_float(__builtin_amdgcn_update_dpp(0, __float_as_int(x), 0x112, 0xF, 0xF, true));
      x += __int_as_float(__builtin_amdgcn_update_dpp(0, __float_as_int(x), 0x114, 0xF, 0xF, true));
      x += __int_as_float(__builtin_amdgcn_update_dpp(0, __float_as_int(x), 0x118, 0xF, 0xF, true));
      lgl[e] = x;
    }
    if (l16 == 15) {
#pragma unroll
      for (int mt = 0; mt < 4; ++mt) *(float4*)(GC + 16 * mt + 4 * q4) = make_float4(__expf(lgl[mt * 4]), __expf(lgl[mt * 4 + 1]), __expf(lgl[mt * 4 + 2]), __expf(lgl[mt * 4 + 3]));
    }
    wave_sync();
  __builtin_amdgcn_sched_barrier(0);
    float n2 = 0.f;
#pragma unroll
    for (int mt = 0; mt < 4; ++mt) {
      const int jo = 16 * mt + 4 * q4;
      float t4[4];
      ld4s(rc[1][mt], rp[1][mt], mu + 512 + hj + jo, t4);
      const float4 kkw = *(const float4*)(P.rk_kk + layer * 512 + hj + jo);
      const float4 kaw = *(const float4*)(P.rk_ka + layer * 512 + hj + jo);
      const float kka[4] = {kkw.x, kkw.y, kkw.z, kkw.w}, kaa[4] = {kaw.x, kaw.y, kaw.z, kaw.w};
#pragma unroll
      for (int r = 0; r < 4; ++r) {
        const int e = mt * 4 + r;
        const float kf = t4[r] * kka[r];
        kk[e] = kf; n2 += kf * kf;
        km[e] = t4[r] * (1.f + (alr[e] - 1.f) * kaa[r]);
      }
    }
    n2 += shx(n2, 16); n2 += shx(n2, 32);
    const float inv = __builtin_amdgcn_rsqf(fmaxf(n2, 1e-24f));
  __builtin_amdgcn_sched_barrier(0);
    float bon = 0.f;
    {
      float At[16], Bt[16], Kt[16];
#pragma unroll
      for (int e = 0; e < 16; ++e) {
        const float lg = lgl[e];
        const float kkn = kk[e] * inv;
        const float ieg = __expf(-lg), egm = __expf(lg - logd[e]), eC = GC[16 * (e >> 2) + 4 * q4 + (e & 3)] * ieg;
        const float bb = kkn * alr[e];
        At[e] = -kkn * egm; Bt[e] = bb * ieg; Kt[e] = km[e] * ieg;
        {
          const int j = 16 * (e >> 2) + 4 * q4 + (e & 3);
          u16* bp = BK + j * 32 + (l16 >> 2) * 8 + (l16 & 3);
          bp[0] = f2bf(bb * eC); bp[4] = f2bf(km[e] * eC);
        }
      }
#pragma unroll
      for (int ks = 0; ks < 2; ++ks) {
        Atf[ks] = pack8(At[ks * 8], At[ks * 8 + 1], At[ks * 8 + 2], At[ks * 8 + 3], At[ks * 8 + 4], At[ks * 8 + 5], At[ks * 8 + 6], At[ks * 8 + 7]);
        Btf[ks] = pack8(Bt[ks * 8], Bt[ks * 8 + 1], Bt[ks * 8 + 2], Bt[ks * 8 + 3], Bt[ks * 8 + 4], Bt[ks * 8 + 5], Bt[ks * 8 + 6], Bt[ks * 8 + 7]);
        Ktf[ks] = pack8(Kt[ks * 8], Kt[ks * 8 + 1], Kt[ks * 8 + 2], Kt[ks * 8 + 3], Kt[ks * 8 + 4], Kt[ks * 8 + 5], Kt[ks * 8 + 6], Kt[ks * 8 + 7]);
      }
    }
#pragma unroll
    for (int mt = 0; mt < 4; ++mt) {
      const int jo = 16 * mt + 4 * q4;
      float t4[4];
      if (PASS == 2) {
        ld4s(rc[0][mt], rp[0][mt], mu + hj + jo, t4);
        const float4 rkw = *(const float4*)(P.rk_rk + layer * 512 + hj + jo);
        const float rka[4] = {rkw.x, rkw.y, rkw.z, rkw.w};
        float rt[4];
#pragma unroll
        for (int r = 0; r < 4; ++r) { const int e = mt * 4 + r; bon += t4[r] * km[e] * rka[r]; rt[r] = t4[r] * __expf(lgl[e]); }
#pragma unroll
        for (int r = 0; r < 4; ++r) Rtf[mt >> 1][(mt & 1) * 4 + r] = (short)f2bf(rt[r]);
      }
      ld4s(rc[2][mt], rp[2][mt], mu + 1024 + hj + jo, t4);
#pragma unroll
      for (int r = 0; r < 4; ++r) VT[(jo + r) * 16 + l16] = f2bf(t4[r]);
    }
    bon += shx(bon, 16); bon += shx(bon, 32);
    if (q4 == 0) BON[l16] = bon;
#pragma unroll
    for (int e = 0; e < 16; ++e) { const int j = 16 * (e >> 2) + 4 * q4 + (e & 3); WT1[j * 16 + l16] = (u16)Atf[e >> 3][e & 7]; }
  }
  __builtin_amdgcn_sched_barrier(0);
  f32x4 Am = MFMA(Atf[0], Btf[0], zero4()); Am = MFMA(Atf[1], Btf[1], Am);
  f32x4 Bm = MFMA(Atf[0], Ktf[0], zero4()); Bm = MFMA(Atf[1], Ktf[1], Bm);
  f32x4 Pm = zero4(), Qm = zero4();
  if (PASS == 2) {
    Pm = MFMA(Rtf[0], Btf[0], zero4()); Pm = MFMA(Rtf[1], Btf[1], Pm);
    Qm = MFMA(Rtf[0], Ktf[0], zero4()); Qm = MFMA(Rtf[1], Ktf[1], Qm);
  }
#pragma unroll
  for (int r = 0; r < 4; ++r) {
    const int t = 4 * q4 + r;
    if (!(l16 < t)) { Am[r] = 0.f; Bm[r] = 0.f; }
    if (!(l16 <= t)) { Pm[r] = 0.f; Qm[r] = 0.f; }
  }
  __builtin_amdgcn_sched_barrier(0);
  *(float4*)(AT + l16 * 16 + 4 * q4) = make_float4(Am[0], Am[1], Am[2], Am[3]);
#pragma unroll
  for (int r = 0; r < 4; ++r) {
    MBM[(4 * q4 + r) * 16 + l16] = f2bf(Bm[r]);
    if (PASS == 2) { M2[(4 * q4 + r) * 32 + l16] = f2bf(Pm[r]); M2[(4 * q4 + r) * 32 + 16 + l16] = f2bf(Qm[r]); }
  }
  wave_sync();
  {
    float xv[16];
#pragma unroll
    for (int t = 0; t < 16; ++t) xv[t] = (t == l16) ? 1.f : 0.f;
#pragma unroll
    for (int s = 0; s < 15; ++s) {
      const float xs = xv[s];
#pragma unroll
      for (int t = s + 1; t < 16; ++t) xv[t] += AT[s * 16 + t] * xs;
    }
#pragma unroll
    for (int t = 0; t < 16; ++t) if ((t >> 2) == q4) M1[t * 16 + l16] = f2bf(xv[t]);
  }
  wave_sync();
  const bf16x4 Tf = *(const bf16x4*)(M1 + l16 * 16 + q4 * 4);
  __builtin_amdgcn_sched_barrier(0);
  unsigned Apk[8], Rpk[8] = {0u, 0u, 0u, 0u, 0u, 0u, 0u, 0u};
  {
    f32x4 Ahp[4];
#pragma unroll
    for (int mt = 0; mt < 4; ++mt) { bf16x4 af = *(const bf16x4*)(WT1 + (16 * mt + l16) * 16 + q4 * 4); Ahp[mt] = MFMA16(af, Tf, zero4()); }
#pragma unroll
    for (int mt = 0; mt < 4; ++mt) { Apk[mt * 2] = pack2(Ahp[mt][0], Ahp[mt][1]); Apk[mt * 2 + 1] = pack2(Ahp[mt][2], Ahp[mt][3]); }
  }
  __builtin_amdgcn_sched_barrier(0);
  if (PASS == 2) {
#pragma unroll
  for (int e = 0; e < 16; ++e) { const int j = 16 * (e >> 2) + 4 * q4 + (e & 3); WT1[j * 16 + l16] = (u16)((Apk[e >> 1] >> ((e & 1) * 16)) & 0xffffu); }
  wave_sync();
  {
    const bf16x4 Pf = *(const bf16x4*)(M2 + l16 * 32 + q4 * 4);
#pragma unroll
    for (int mt = 0; mt < 4; ++mt) {
      bf16x4 af = *(const bf16x4*)(WT1 + (16 * mt + l16) * 16 + q4 * 4);
      f32x4 ci;
#pragma unroll
      for (int r = 0; r < 4; ++r) ci[r] = bf2f((u16)Rtf[mt >> 1][(mt & 1) * 4 + r]);
      f32x4 rh = MFMA16(af, Pf, ci);
      Rpk[mt * 2] = pack2(rh[0], rh[1]); Rpk[mt * 2 + 1] = pack2(rh[2], rh[3]);
    }
  }
  }
  __builtin_amdgcn_sched_barrier(0);
  {
    const bf16x4 Bmf = *(const bf16x4*)(MBM + l16 * 16 + q4 * 4);
    f32x4 BVp[4];
#pragma unroll
    for (int mt = 0; mt < 4; ++mt) { bf16x4 af = *(const bf16x4*)(VT + (16 * mt + l16) * 16 + q4 * 4); BVp[mt] = MFMA16(af, Bmf, zero4()); }
    wave_sync();
#pragma unroll
    for (int e = 0; e < 16; ++e) { const int i = 16 * (e >> 2) + 4 * q4 + (e & 3); WT2[i * 16 + l16] = f2bf(BVp[e >> 2][e & 3]); }
    wave_sync();
    f32x4 uv[4];
#pragma unroll
    for (int nt = 0; nt < 4; ++nt) { bf16x4 bf = *(const bf16x4*)(WT2 + (16 * nt + l16) * 16 + q4 * 4); uv[nt] = MFMA16(Tf, bf, zero4()); }
    wave_sync();
#pragma unroll
    for (int nt = 0; nt < 4; ++nt) {
#pragma unroll
      for (int r = 0; r < 4; ++r) UV[(nt * 4 + r) * 64 + lane] = f2bf(uv[nt][r]);
      if (PASS == 2) {
        const int i = 16 * nt + l16;
        uint2 o; o.x = pack2(uv[nt][0], uv[nt][1]); o.y = pack2(uv[nt][2], uv[nt][3]);
        *(uint2*)(WT3 + i * 32 + 4 * q4) = o;
        *(uint2*)(WT3 + i * 32 + 16 + 4 * q4) = *(const uint2*)(VT + i * 16 + 4 * q4);
      }
    }
  }
  __builtin_amdgcn_sched_barrier(0);
  wave_sync();
  if (PASS == 2) {
    const bf16x8 PQf = *(const bf16x8*)(M2 + l16 * 32 + q4 * 8);
    f32x4 wv[4];
#pragma unroll
    for (int nt = 0; nt < 4; ++nt) { bf16x8 bf = *(const bf16x8*)(WT3 + (16 * nt + l16) * 32 + q4 * 8); wv[nt] = MFMA(PQf, bf, zero4()); }
    wave_sync();
#pragma unroll
    for (int nt = 0; nt < 4; ++nt)
#pragma unroll
      for (int r = 0; r < 4; ++r) WV[(nt * 4 + r) * 64 + lane] = f2bf(wv[nt][r]);
  }
  __builtin_amdgcn_sched_barrier(0);
  {
    if (PASS == 2) {
      *(uint4*)(RH + (l16 * 4 + q4) * 16) = make_uint4(Rpk[0], Rpk[1], Rpk[2], Rpk[3]);
      *(uint4*)(RH + (l16 * 4 + q4) * 16 + 8) = make_uint4(Rpk[4], Rpk[5], Rpk[6], Rpk[7]);
    }
    *(uint4*)(AH + (l16 * 4 + q4) * 16) = make_uint4(Apk[0], Apk[1], Apk[2], Apk[3]);
    *(uint4*)(AH + (l16 * 4 + q4) * 16 + 8) = make_uint4(Apk[4], Apk[5], Apk[6], Apk[7]);
  }
}

template <int PASS>
__device__ void rwkv_seg(const Params& P, int layer, int chain, int seg, char* lds) {
  const int tid = TIDX_f(), lane = tid & 63, w = tid >> 6, l16 = lane & 15, q4 = lane >> 4;
  const int b = chain >> 3, h = chain & 7;
  f32x4 ST[4], ET[4];
#pragma unroll
  for (int i = 0; i < 4; ++i) { ST[i] = zero4(); ET[i] = zero4(); }
  const int ich = h * 64 + 16 * w + l16;
  const float lnG = P.rk_lnx_g[layer * 512 + ich], lnB = P.rk_lnx_b[layer * 512 + ich];
  __syncthreads();
  if (PASS == 1) {
#pragma unroll
    for (int nt = 0; nt < 4; ++nt)
#pragma unroll
      for (int r = 0; r < 4; ++r) ET[nt][r] = ((16 * nt + 4 * q4 + r) == (16 * w + l16)) ? 1.f : 0.f;
  } else if (seg > 0) {
    float* Sa = (float*)lds; float* Sb = Sa + 4096; float* Mb = Sb + 4096;
    const int i = tid >> 2, jq = tid & 3;
    for (int e = tid; e < 4096; e += 256) Sa[e] = 0.f;
    for (int s = 0; s < seg; ++s) {
      const float* G = P.mg + ((long)(chain * 8 + s) * 2) * 4096; const float* M = G + 4096;
      __syncthreads();
      for (int e = tid; e < 1024; e += 256) *(float4*)(Mb + e * 4) = *(const float4*)(M + e * 4);
      float acc[16];
#pragma unroll
      for (int q = 0; q < 4; ++q) { float4 g4 = *(const float4*)(G + i * 64 + jq * 16 + q * 4); acc[q * 4] = g4.x; acc[q * 4 + 1] = g4.y; acc[q * 4 + 2] = g4.z; acc[q * 4 + 3] = g4.w; }
      __syncthreads();
      for (int k = 0; k < 64; ++k) {
        const float sik = Sa[i * 64 + k];
#pragma unroll
        for (int q = 0; q < 4; ++q) { float4 m4 = *(const float4*)(Mb + k * 64 + jq * 16 + q * 4); acc[q * 4] += sik * m4.x; acc[q * 4 + 1] += sik * m4.y; acc[q * 4 + 2] += sik * m4.z; acc[q * 4 + 3] += sik * m4.w; }
      }
#pragma unroll
      for (int q = 0; q < 4; ++q) *(float4*)(Sb + i * 64 + jq * 16 + q * 4) = make_float4(acc[q * 4], acc[q * 4 + 1], acc[q * 4 + 2], acc[q * 4 + 3]);
      float* t = Sa; Sa = Sb; Sb = t;
    }
    __syncthreads();
#pragma unroll
    for (int nt = 0; nt < 4; ++nt) { float4 v = *(const float4*)(Sa + (16 * w + l16) * 64 + 16 * nt + 4 * q4); ST[nt][0] = v.x; ST[nt][1] = v.y; ST[nt][2] = v.z; ST[nt][3] = v.w; }
  }
  for (int rd = seg * 16; rd < seg * 16 + 16; ++rd) {
    __syncthreads();
    rwkv_precompute<PASS>(P, layer, b, h, rd * 4 + w, lds + w * SL_SIZE);
    __syncthreads();
    unsigned touch0 = 0, touch1 = 0;
    if (rd + 1 < seg * 16 + 16) {
      const u16* base = P.proj + ((long)b * SEQ + ((rd + 1) * 4 + w) * 16 - 1) * LD + C_RS;
      { const int id = lane; const int row = id / 5, q = id - row * 5; const int cb = (q < 3) ? (q * 512 + h * 64) : (1536 + (q - 3) * 64);
        touch0 = *(const volatile unsigned*)(base + (long)row * LD + cb); }
      if (lane + 64 < 85) { const int id = lane + 64; const int row = id / 5, q = id - row * 5; const int cb = (q < 3) ? (q * 512 + h * 64) : (1536 + (q - 3) * 64);
        touch1 = *(const volatile unsigned*)(base + (long)row * LD + cb); }
    }
    f32x4 Y[4];
#pragma unroll
    for (int cc = 0; cc < 4; ++cc) {
      const char* sl = lds + cc * SL_SIZE;
      const u16* RH = (const u16*)(sl + SL_RH); const u16* AH = (const u16*)(sl + SL_AH); const u16* WV = (const u16*)(sl + SL_WV); const u16* UV = (const u16*)(sl + SL_UV);
      const u16* BK = (const u16*)(sl + SL_BK); const u16* VT = (const u16*)(sl + SL_VT); const float* GC = (const float*)(sl + SL_GC);
      bf16x8 sop[2];
      sop[0] = pack8(ST[0][0], ST[0][1], ST[0][2], ST[0][3], ST[1][0], ST[1][1], ST[1][2], ST[1][3]);
      sop[1] = pack8(ST[2][0], ST[2][1], ST[2][2], ST[2][3], ST[3][0], ST[3][1], ST[3][2], ST[3][3]);
      const bf16x8 af0 = *(const bf16x8*)(AH + (l16 * 4 + q4) * 16), af1 = *(const bf16x8*)(AH + (l16 * 4 + q4) * 16 + 8);
      f32x4 ua;
#pragma unroll
      for (int r = 0; r < 4; ++r) ua[r] = bf2f(UV[(w * 4 + r) * 64 + lane]);
      ua = MFMA(af0, sop[0], ua); ua = MFMA(af1, sop[1], ua);
      if (PASS == 2) {
        f32x4 ya;
#pragma unroll
        for (int r = 0; r < 4; ++r) ya[r] = bf2f(WV[(w * 4 + r) * 64 + lane]);
        ya = MFMA(*(const bf16x8*)(RH + (l16 * 4 + q4) * 16), sop[0], ya);
        ya = MFMA(*(const bf16x8*)(RH + (l16 * 4 + q4) * 16 + 8), sop[1], ya);
        Y[cc] = ya;
      }
      bf16x4 v4 = *(const bf16x4*)(VT + (16 * w + l16) * 16 + 4 * q4);
      u32x4_t bt = {pack2(ua[0], ua[1]), pack2(ua[2], ua[3]), 0u, 0u};
      bf16x8 bop = __builtin_bit_cast(bf16x8, bt);
      bop[4] = v4[0]; bop[5] = v4[1]; bop[6] = v4[2]; bop[7] = v4[3];
      bf16x8 bope = zero8();
      if (PASS == 1) {
        bf16x8 eop0 = pack8(ET[0][0], ET[0][1], ET[0][2], ET[0][3], ET[1][0], ET[1][1], ET[1][2], ET[1][3]);
        bf16x8 eop1 = pack8(ET[2][0], ET[2][1], ET[2][2], ET[2][3], ET[3][0], ET[3][1], ET[3][2], ET[3][3]);
        f32x4 xe = MFMA(af0, eop0, zero4()); xe = MFMA(af1, eop1, xe);
        u32x4_t et = {pack2(xe[0], xe[1]), pack2(xe[2], xe[3]), 0u, 0u};
        bope = __builtin_bit_cast(bf16x8, et);
      }
#pragma unroll
      for (int nt = 0; nt < 4; ++nt) {
        const float4 g4 = *(const float4*)(GC + 16 * nt + 4 * q4);
        const bf16x8 bkf = *(const bf16x8*)(BK + (16 * nt + l16) * 32 + q4 * 8);
        f32x4 ci = {ST[nt][0] * g4.x, ST[nt][1] * g4.y, ST[nt][2] * g4.z, ST[nt][3] * g4.w};
        ST[nt] = MFMA(bkf, bop, ci);
        if (PASS == 1) {
          f32x4 ce = {ET[nt][0] * g4.x, ET[nt][1] * g4.y, ET[nt][2] * g4.z, ET[nt][3] * g4.w};
          ET[nt] = MFMA(bkf, bope, ce);
        }
      }
    }
    if (PASS == 2) {
#pragma unroll
      for (int cc = 0; cc < 4; ++cc) {
        float* stt = (float*)(lds + cc * SL_SIZE + SL_M2);
#pragma unroll
        for (int r = 0; r < 4; ++r) {
          float s1 = red16_sum(Y[cc][r]), s2 = red16_sum(Y[cc][r] * Y[cc][r]);
          if (l16 == 0) { stt[(w * 16 + 4 * q4 + r) * 2] = s1; stt[(w * 16 + 4 * q4 + r) * 2 + 1] = s2; }
        }
      }
      __syncthreads();
#pragma unroll
      for (int cc = 0; cc < 4; ++cc) {
        const char* sl = lds + cc * SL_SIZE;
        const float* stt = (const float*)(sl + SL_M2); const float* BON = (const float*)(sl + SL_BON); const u16* VT = (const u16*)(sl + SL_VT);
        bf16x4 v4 = *(const bf16x4*)(VT + (16 * w + l16) * 16 + 4 * q4);
#pragma unroll
        for (int r = 0; r < 4; ++r) {
          const int t = 4 * q4 + r;
          float s1 = 0.f, s2 = 0.f;
#pragma unroll
          for (int ww = 0; ww < 4; ++ww) { s1 += stt[(ww * 16 + t) * 2]; s2 += stt[(ww * 16 + t) * 2 + 1]; }
          const float mean = s1 * (1.f / 64.f), var = fmaxf(s2 * (1.f / 64.f) - mean * mean, 0.f);
          const float yn = (Y[cc][r] - mean) * rsqrtf(var + 64e-5f) * lnG + lnB + BON[t] * bf2f((u16)v4[r]);
          u16* op = P.proj + ((long)b * SEQ + (rd * 4 + cc) * 16 + t) * LD + C_RZ + ich;
          const float z = bf2f(*op);
          *op = f2bf(yn * siluf_(z));
        }
      }
    }
    asm volatile("" ::"v"(touch0), "v"(touch1));
  }
  if (PASS == 1) {
    float* G = P.mg + ((long)(chain * 8 + seg) * 2) * 4096; float* M = G + 4096;
#pragma unroll
    for (int nt = 0; nt < 4; ++nt) {
      *(float4*)(G + (16 * w + l16) * 64 + 16 * nt + 4 * q4) = make_float4(ST[nt][0], ST[nt][1], ST[nt][2], ST[nt][3]);
      *(float4*)(M + (16 * w + l16) * 64 + 16 * nt + 4 * q4) = make_float4(ET[nt][0], ET[nt][1], ET[nt][2], ET[nt][3]);
    }
  }
  __syncthreads();
}

__device__ void phase_mid1(const Params& P, int layer, char* lds) {
  const int gw = BIDX_f() * 4 + (TIDX_f() >> 6), nw = gridDim.x * 4;
  for (int i = BIDX_f() * 256 + TIDX_f(); i < TOK; i += gridDim.x * 256) P.rstd2[i] = 0.f;
  for (int it = gw; it < 1024; it += nw) compress_item(P, layer, it);
  for (int it = BIDX_f(); it < 2048; it += gridDim.x) sgprep_item(P, layer, it, lds);
}

__device__ void phase_mid2(const Params& P, int layer, char* lds, int* s_item) {
  for (int task = BIDX_f(); task < 512; task += gridDim.x) rwkv_seg<2>(P, layer, task >> 3, task & 7, lds);
  const int w = TIDX_f() >> 6;
  int* ctr = P.ctr + layer;
  for (;;) {
    __syncthreads();
    if (TIDX_f() == 0) *s_item = atomicAdd(ctr, 1);
    __syncthreads();
    const int it = *s_item;
    if (it >= 8192 + 4096) break;
    if (it < 8192) nsa_item(P, it * 4 + w, lds + w * 11008);
    else sg_item(P, layer, (it - 8192) * 4 + w);
  }
}

__global__ void __launch_bounds__(256, 2) mega(Params P) {
  __shared__ __attribute__((aligned(16))) char lds[65536];
  __shared__ int s_item;
  phase_weights(P, lds);
  phase_rstd(P.x, P.rstd, P.hb, false);
  cg::this_grid().sync();
  for (int layer = 0; layer < 2; ++layer) {
    const float* xin = layer == 0 ? P.x : P.out;
    phase_inproj(P, layer, xin, lds);
    cg::this_grid().sync();
    phase_mid1(P, layer, lds);
    cg::this_grid().sync();
    for (int task = BIDX_f(); task < 448; task += gridDim.x) rwkv_seg<1>(P, layer, task / 7, task % 7, lds);
    cg::this_grid().sync();
    phase_mid2(P, layer, lds, &s_item);
    cg::this_grid().sync();
    phase_merge(P, layer, xin, lds);
    cg::this_grid().sync();
    phase_wo(P, layer, xin, P.out, lds);
    cg::this_grid().sync();
    phase_ple(P, layer, P.out, lds);
    cg::this_grid().sync();
    if (layer == 0) { phase_rstd(P.out, P.rstd, P.hb, false); cg::this_grid().sync(); }
  }
  phase_final_norm(P.out, P.final_norm_g);
}

extern "C" void kernel_launch(void* const* d_in, const int* in_sizes, int n_in, void* d_out, int out_size, void* d_ws, size_t ws_size, hipStream_t stream) {
  static int grid_blocks = 0;
  if (!grid_blocks) {
    int dev = 0, cus = 0, per_cu = 0;
    hipGetDevice(&dev);
    hipDeviceGetAttribute(&cus, hipDeviceAttributeMultiprocessorCount, dev);
    hipOccupancyMaxActiveBlocksPerMultiprocessor(&per_cu, (const void*)mega, 256, 0);
    if (per_cu < 1) per_cu = 1;
    if (per_cu > 2) per_cu = 2;
    grid_blocks = (cus * per_cu) & ~7;
    if (grid_blocks < 8) grid_blocks = 8;
  }
  Params P{};
  const float** pf = (const float**)&P;
  for (int i = 0; i < 27; ++i) pf[i] = (const float*)d_in[i];
  P.out = (float*)d_out;
  char* ws = (char*)d_ws; size_t off = 0;
  auto take = [&](size_t bytes) { char* p = ws + off; off += (bytes + 255) & ~(size_t)255; return p; };
  P.WinT = (u16*)take((size_t)2 * LD * 1024 * 2);
  P.WmgT = (u16*)take((size_t)2 * 3072 * 1024 * 2);
  P.WbrT = (u16*)take((size_t)2 * 3 * 1024 * 512 * 2);
  P.WoT = (u16*)take((size_t)2 * 1024 * 1024 * 2);
  P.WgT = (u16*)take((size_t)2 * 1024 * 1024 * 2);
  P.WpT = (u16*)take((size_t)2 * 1024 * 256 * 2);
  P.W1T = (u16*)take((size_t)4 * 128 * 2048 * 2);
  P.W2T = (u16*)take((size_t)4 * 64 * 128 * 2);
  P.sgW = (u16*)take((size_t)2 * 8 * 128 * 128 * 2);
  P.w2T = (u16*)take((size_t)2 * 512 * 64 * 2);
  P.a2T = (u16*)take((size_t)2 * 512 * 64 * 2);
  P.kc = (u16*)take((size_t)16 * 512 * 64 * 2);
  P.vcT = (u16*)take((size_t)16 * 64 * 512 * 2);
  P.vsT = (u16*)take((size_t)16 * 64 * SEQ * 2);
  P.vwT = (u16*)take((size_t)16 * 64 * SEQ * 2);
  P.vnT = (u16*)take((size_t)8 * 512 * SEQ * 2);
  P.proj = (u16*)take((size_t)TOK * LD * 2);
  P.hb = (u16*)take((size_t)TOK * 1024 * 2);
  P.c1 = (float*)take(512 * 4);
  P.rstd = (float*)take((size_t)TOK * 4);
  P.rstd2 = (float*)take((size_t)TOK * 4);
  P.mg = (float*)take((size_t)64 * 8 * 2 * 4096 * 4);
  P.ctr = (int*)take(256);
  if (off > ws_size) { fprintf(stderr, "workspace too small: need %zu have %zu\n", off, ws_size); return; }
  void* args[] = {&P};
  hipError_t e = hipLaunchCooperativeKernel((const void*)mega, dim3(grid_blocks), dim3(256), args, 0, stream);
  if (e != hipSuccess) fprintf(stderr, "cooperative launch failed: %s (grid %d)\n", hipGetErrorString(e), grid_blocks);
}
```
